# Optimizing an MI355X kernel written in HIP

```python
import jax, jax.numpy as jnp
from jax import lax
import numpy as np

D_MODEL = 1024
BATCH = 4
SEQ = 8192
DEPTH = 2

CHUNK = 64
LEFT_CHUNKS = 8
BAND = (LEFT_CHUNKS + 1) * CHUNK
MAX_REL = 128
Q_BLOCK = 128

HEAD_DIM = 64
N_HEADS_A = D_MODEL // (2 * HEAD_DIM)
N_HEADS_B = D_MODEL // (2 * HEAD_DIM)
AB_COLS = 3 * (N_HEADS_A + N_HEADS_B) * HEAD_DIM
AB_OUT = (N_HEADS_A + N_HEADS_B) * HEAD_DIM
N_HEADS_C = D_MODEL // (2 * HEAD_DIM)
QK_NOPE = HEAD_DIM
QK_ROPE = HEAD_DIM // 2
V_DIM_C = HEAD_DIM
Q_RANK = 3 * D_MODEL // 8
KV_RANK = D_MODEL // 4
N_HEADS_D = D_MODEL // (2 * HEAD_DIM)
CD_SPLITS = [Q_RANK, KV_RANK, QK_ROPE, N_HEADS_D * HEAD_DIM, N_HEADS_D * HEAD_DIM, N_HEADS_D * HEAD_DIM, N_HEADS_D]
CD_COLS = sum(CD_SPLITS)
CD_OUT = N_HEADS_C * V_DIM_C + N_HEADS_D * HEAD_DIM
ROPE_THETA = 10000.0
D_FF = ((8 * D_MODEL // 3) + 127) // 128 * 128
CONV_WIDTH = 3
RMS_EPS = 1e-6
N_EVEN = (DEPTH + 1) // 2
N_ODD = DEPTH // 2

kernel_name = 'hybrid_chunk_stick_mla_fox_convffn'


def rmsnorm(x, g):
    x32 = x.astype(jnp.float32)
    y = x32 * lax.rsqrt(jnp.mean(x32 * x32, axis=-1, keepdims=True) + RMS_EPS)
    return (y * g.astype(jnp.float32)).astype(x.dtype)


def rope(x, positions):
    half = x.shape[-1] // 2
    inv = ROPE_THETA ** (-jnp.arange(half, dtype=jnp.float32) / half)
    ang = positions.astype(jnp.float32)[:, None] * inv[None, :]
    ang = ang.reshape((ang.shape[0],) + (1,) * (x.ndim - 3) + (half,))
    cos, sin = jnp.cos(ang), jnp.sin(ang)
    x32 = x.astype(jnp.float32)
    x1, x2 = x32[..., :half], x32[..., half:]
    return jnp.concatenate([x1 * cos - x2 * sin, x2 * cos + x1 * sin], axis=-1).astype(x.dtype)


def sweep_query_blocks(block_fn, seq):
    out = lax.map(block_fn, jnp.arange(seq // Q_BLOCK))
    nb, b, qb, h, dv = out.shape
    return jnp.transpose(out, (1, 0, 2, 3, 4)).reshape(b, nb * qb, h, dv)


def chunked_relpos_attention(q, k, v, rel_bias):
    b, s, h, d = q.shape
    pad = LEFT_CHUNKS * CHUNK
    kp = jnp.pad(k, ((0, 0), (pad, 0), (0, 0), (0, 0)))
    vp = jnp.pad(v, ((0, 0), (pad, 0), (0, 0), (0, 0)))
    qi = np.arange(CHUNK)[:, None]
    kj = np.arange(BAND)[None, :]
    rel_idx = np.clip(qi + pad - kj, -MAX_REL, MAX_REL) + MAX_REL
    bias = rel_bias[:, rel_idx].astype(jnp.float32)
    scale = d ** -0.5
    band_pos = jnp.arange(BAND)

    def chunk_fn(c):
        start = c * CHUNK
        qc = lax.dynamic_slice_in_dim(q, start, CHUNK, axis=1)
        kb = lax.dynamic_slice_in_dim(kp, start, BAND, axis=1)
        vb = lax.dynamic_slice_in_dim(vp, start, BAND, axis=1)
        logits = jnp.einsum('bqhd,bkhd->bhqk', qc, kb).astype(jnp.float32) * scale + bias
        valid = (start - pad + band_pos) >= 0
        logits = jnp.where(valid, logits, -jnp.inf)
        p = jax.nn.softmax(logits, axis=-1)
        return jnp.einsum('bhqk,bkhd->bqhd', p.astype(vb.dtype), vb)

    out = lax.map(chunk_fn, jnp.arange(s // CHUNK))
    return jnp.transpose(out, (1, 0, 2, 3, 4)).reshape(b, s, h, d)


def stick_breaking_attention(q, k, v):
    b, s, h, d = q.shape
    scale = d ** -0.5
    key_pos = jnp.arange(s)

    def block_fn(blk):
        start = blk * Q_BLOCK
        qb = lax.dynamic_slice_in_dim(q, start, Q_BLOCK, axis=1)
        z = jnp.einsum('bqhd,bkhd->bhqk', qb, k).astype(jnp.float32) * scale
        q_pos = start + jnp.arange(Q_BLOCK)
        mask = key_pos[None, :] < q_pos[:, None]
        log_keep = jnp.where(mask, jax.nn.log_sigmoid(-z), 0.0)
        later = lax.cumsum(log_keep, axis=3, reverse=True) - log_keep
        w = jnp.where(mask, jnp.exp(jax.nn.log_sigmoid(z) + later), 0.0)
        return jnp.einsum('bhqk,bkhd->bqhd', w.astype(v.dtype), v)

    return sweep_query_blocks(block_fn, s)


def mla_attention(q_nope, q_rope, k_nope, k_rope, v):
    s = q_nope.shape[1]
    scale = (QK_NOPE + QK_ROPE) ** -0.5
    key_chunk = jnp.arange(s) // CHUNK

    def block_fn(blk):
        start = blk * Q_BLOCK
        qn = lax.dynamic_slice_in_dim(q_nope, start, Q_BLOCK, axis=1)
        qr = lax.dynamic_slice_in_dim(q_rope, start, Q_BLOCK, axis=1)
        logits = (jnp.einsum('bqhd,bkhd->bhqk', qn, k_nope)
                  + jnp.einsum('bqhr,bkr->bhqk', qr, k_rope)).astype(jnp.float32) * scale
        q_chunk = (start + jnp.arange(Q_BLOCK)) // CHUNK
        mask = key_chunk[None, :] <= q_chunk[:, None]
        p = jax.nn.softmax(jnp.where(mask, logits, -jnp.inf), axis=-1)
        return jnp.einsum('bhqk,bkhd->bqhd', p.astype(v.dtype), v)

    return sweep_query_blocks(block_fn, s)


def forgetting_attention(q, k, v, log_f):
    b, s, h, d = q.shape
    scale = d ** -0.5
    cum = jnp.transpose(jnp.cumsum(log_f, axis=1), (0, 2, 1))
    key_pos = jnp.arange(s)

    def block_fn(blk):
        start = blk * Q_BLOCK
        qb = lax.dynamic_slice_in_dim(q, start, Q_BLOCK, axis=1)
        cum_q = lax.dynamic_slice_in_dim(cum, start, Q_BLOCK, axis=2)
        logits = (jnp.einsum('bqhd,bkhd->bhqk', qb, k).astype(jnp.float32) * scale
                  + cum_q[..., None] - cum[:, :, None, :])
        q_pos = start + jnp.arange(Q_BLOCK)
        mask = key_pos[None, :] <= q_pos[:, None]
        p = jax.nn.softmax(jnp.where(mask, logits, -jnp.inf), axis=-1)
        return jnp.einsum('bhqk,bkhd->bqhd', p.astype(v.dtype), v)

    return sweep_query_blocks(block_fn, s)


def chunk_stick_layer(x, norm_g, w_in, rel_bias, w_o):
    b, s, _ = x.shape
    h = rmsnorm(x, norm_g)
    proj = h @ w_in
    qa, ka, va, qb, kb, vb = jnp.split(proj, 6, axis=-1)
    shp = (b, s, N_HEADS_A, HEAD_DIM)
    oa = chunked_relpos_attention(qa.reshape(shp), ka.reshape(shp), va.reshape(shp), rel_bias)
    shp_b = (b, s, N_HEADS_B, HEAD_DIM)
    ob = stick_breaking_attention(qb.reshape(shp_b), kb.reshape(shp_b), vb.reshape(shp_b))
    o = jnp.concatenate([oa, ob], axis=2).reshape(b, s, AB_OUT)
    return x + o @ w_o


def mla_fox_layer(x, norm_g, w_in, q_norm, w_uq, kv_norm, w_ukv, b_f, w_o):
    b, s, _ = x.shape
    h = rmsnorm(x, norm_g)
    proj = h @ w_in
    c_q, c_kv, k_rope, q_d, k_d, v_d, f_logit = jnp.split(proj, list(np.cumsum(CD_SPLITS)[:-1]), axis=-1)
    positions = jnp.arange(s)
    q_c = (rmsnorm(c_q, q_norm) @ w_uq).reshape(b, s, N_HEADS_C, QK_NOPE + QK_ROPE)
    kv_c = (rmsnorm(c_kv, kv_norm) @ w_ukv).reshape(b, s, N_HEADS_C, QK_NOPE + V_DIM_C)
    q_nope, q_rope = q_c[..., :QK_NOPE], rope(q_c[..., QK_NOPE:], positions)
    k_nope, v_c = kv_c[..., :QK_NOPE], kv_c[..., QK_NOPE:]
    oc = mla_attention(q_nope, q_rope, k_nope, rope(k_rope, positions), v_c)
    log_f = jax.nn.log_sigmoid((f_logit + b_f).astype(jnp.float32))
    shp = (b, s, N_HEADS_D, HEAD_DIM)
    od = forgetting_attention(q_d.reshape(shp), k_d.reshape(shp), v_d.reshape(shp), log_f)
    o = jnp.concatenate([oc, od], axis=2).reshape(b, s, CD_OUT)
    return x + o @ w_o


def conv_gated_mlp(x, norm_g, w_gate, w_up, conv_w, conv_b, w_down):
    h = rmsnorm(x, norm_g)
    g = h @ w_gate
    g = lax.conv_general_dilated(g, conv_w[:, None, :], window_strides=(1,),
                                 padding=[(CONV_WIDTH - 1, 0)],
                                 dimension_numbers=('NWC', 'WIO', 'NWC'),
                                 feature_group_count=g.shape[-1]) + conv_b
    y = jax.nn.silu(g) * (h @ w_up)
    return x + y @ w_down


def setup_inputs(seed: int = 0) -> dict:
    key = jax.random.key(seed)
    ks = iter(jax.random.split(key, 32))

    def nrm(shape, scale):
        return jax.random.normal(next(ks), shape, jnp.float32) * scale

    def gain(shape):
        return 1.0 + nrm(shape, 0.05)

    return {
        'x': nrm((BATCH, SEQ, D_MODEL), 1.0),
        'ab_norm': gain((N_EVEN, D_MODEL)),
        'ab_w_in': nrm((N_EVEN, D_MODEL, AB_COLS), D_MODEL ** -0.5),
        'ab_rel_bias': nrm((N_EVEN, N_HEADS_A, 2 * MAX_REL + 1), 0.5),
        'ab_w_o': nrm((N_EVEN, AB_OUT, D_MODEL), AB_OUT ** -0.5),
        'cd_norm': gain((N_ODD, D_MODEL)),
        'cd_w_in': nrm((N_ODD, D_MODEL, CD_COLS), D_MODEL ** -0.5),
        'cd_q_norm': gain((N_ODD, Q_RANK)),
        'cd_w_uq': nrm((N_ODD, Q_RANK, N_HEADS_C * (QK_NOPE + QK_ROPE)), Q_RANK ** -0.5),
        'cd_kv_norm': gain((N_ODD, KV_RANK)),
        'cd_w_ukv': nrm((N_ODD, KV_RANK, N_HEADS_C * (QK_NOPE + V_DIM_C)), KV_RANK ** -0.5),
        'cd_b_f': 3.0 + nrm((N_ODD, N_HEADS_D), 0.5),
        'cd_w_o': nrm((N_ODD, CD_OUT, D_MODEL), CD_OUT ** -0.5),
        'ffn_norm': gain((DEPTH, D_MODEL)),
        'ffn_w_gate': nrm((DEPTH, D_MODEL, D_FF), D_MODEL ** -0.5),
        'ffn_w_up': nrm((DEPTH, D_MODEL, D_FF), D_MODEL ** -0.5),
        'ffn_conv_w': nrm((DEPTH, CONV_WIDTH, D_FF), CONV_WIDTH ** -0.5),
        'ffn_conv_b': nrm((DEPTH, D_FF), 0.02),
        'ffn_w_down': nrm((DEPTH, D_FF, D_MODEL), D_FF ** -0.5),
        'final_norm': gain((D_MODEL,)),
    }


def reference(x, ab_norm, ab_w_in, ab_rel_bias, ab_w_o,
              cd_norm, cd_w_in, cd_q_norm, cd_w_uq, cd_kv_norm, cd_w_ukv, cd_b_f, cd_w_o,
              ffn_norm, ffn_w_gate, ffn_w_up, ffn_conv_w, ffn_conv_b, ffn_w_down,
              final_norm):
    for layer in range(DEPTH):
        i = layer // 2
        if layer % 2 == 0:
            x = chunk_stick_layer(x, ab_norm[i], ab_w_in[i], ab_rel_bias[i], ab_w_o[i])
        else:
            x = mla_fox_layer(x, cd_norm[i], cd_w_in[i], cd_q_norm[i], cd_w_uq[i], cd_kv_norm[i],
                              cd_w_ukv[i], cd_b_f[i], cd_w_o[i])
        x = conv_gated_mlp(x, ffn_norm[layer], ffn_w_gate[layer], ffn_w_up[layer],
                           ffn_conv_w[layer], ffn_conv_b[layer], ffn_w_down[layer])
    return rmsnorm(x, final_norm)
```

```cpp
#include <hip/hip_runtime.h>
#include <hip/hip_cooperative_groups.h>
#include <cstdio>
#include <cstdint>
namespace cg = cooperative_groups;

constexpr int BATCH = 4, SEQ = 8192, DM = 1024, MTOK = BATCH * SEQ;
constexpr int AB_COLS = 3072, CD_COLS = 2216, CD_PAD = 2304, FF = 2816, FF2 = 2 * FF;
constexpr int Q_RANK = 384, KV_RANK = 256, QC_COLS = 768, KVC_COLS = 1024;
constexpr float RMS_EPS = 1e-6f, LOG2E = 1.4426950408889634f;
namespace pg8 {
#define PG8_LAS __attribute__((address_space(3)))
typedef unsigned short bf16_t;
typedef short bf16x8 __attribute__((ext_vector_type(8)));
typedef float f32x4 __attribute__((ext_vector_type(4)));
typedef unsigned u32x4 __attribute__((ext_vector_type(4)));
constexpr int BM = 256, BK = 64, HALF = 128, HTB = HALF * BK * 2  , STAGE_BYTES = 8 * HTB, NXCD = 8, WGM = 8;

__host__ __device__ __forceinline__ int lds_byte(int r, int c) { const int st = (r >> 4) * 2 + (c >> 5), rr = r & 15, cc = c & 31, ob = rr * 64 + cc * 2; return st * 1024 + (ob ^ (((ob >> 9) & 1) << 5)); }
__host__ __device__ __forceinline__ void stage_rc(int b, int& R, int& C) { const int st = b / 1024, sb = b % 1024, swz = sb ^ (((sb >> 9) & 1) << 5); R = (st >> 1) * 16 + swz / 64; C = (st & 1) * 32 + (swz % 64) / 2; }
__host__ __device__ __forceinline__ int perm32(int rho) { const int n = rho >> 4, i = rho & 15; return 8 * (i >> 2) + 4 * n + (i & 3); }

struct Unit { int pm, pn; };
struct Gemm { const bf16_t* A; const bf16_t* Bt; int M, N, K, lda; };

struct StaticOrder {
    int nM, nN, nwg, G, c;
    __host__ __device__ void init(int M, int N, int G_, int c_) { nM = M / BM; nN = N / BM; nwg = nM * nN; G = G_; c = c_; }
    __host__ __device__ bool next(int i, Unit& u) const {
        const long L = (long)i * G + c; if (L >= nwg) return false;
        int wgid = (int)L; { const int q = nwg / NXCD, r = nwg % NXCD, xcd = wgid % NXCD, off = wgid / NXCD; wgid = (xcd < r ? xcd * (q + 1) : r * (q + 1) + (xcd - r) * q) + off; }
        const int nig = WGM * nN, gid = wgid / nig, fm = gid * WGM, gsz = (nM - fm) < WGM ? (nM - fm) : WGM;
        u.pm = fm + ((wgid % nig) % gsz); u.pn = (wgid % nig) / gsz; return true;
    }
    __device__ __forceinline__ void a_ready(const Unit&) const {}
    __device__ __forceinline__ void done(const Unit&) const {}
};

__device__ __forceinline__ unsigned cvt_pk_bf16(float lo, float hi) { unsigned r; asm volatile("v_cvt_pk_bf16_f32 %0, %1, %2" : "=v"(r) : "v"(lo), "v"(hi)); return r; }
typedef unsigned u32x2 __attribute__((ext_vector_type(2)));
typedef float f32x2 __attribute__((ext_vector_type(2)));

struct EpiScaleBf16 {
    static constexpr bool PERM = true, AFTER_DRAIN = false;
    bf16_t* O; int ldc; const float* ss; float inv_n;
    __device__ __forceinline__ void operator()(const f32x4 (&acc)[2][2][4][2], const Unit& u, int wr, int wc, int fr, int fq) const {
        const int row0 = u.pm * BM + wr * 64 + fr; const int col0 = u.pn * BM + wc * 32 + 8 * fq;
#pragma unroll
        for (int ai = 0; ai < 2; ++ai)
#pragma unroll
            for (int m = 0; m < 4; ++m) { const int row = row0 + ai * HALF + m * 16; const float rs = rsqrtf(ss[row] * inv_n + RMS_EPS); bf16_t* rowp = O + (size_t)row * ldc + col0;
#pragma unroll
                for (int bj = 0; bj < 2; ++bj) { const f32x4 v0 = acc[ai][bj][m][0] * rs, v1 = acc[ai][bj][m][1] * rs;
                    u32x4 w; w.x = cvt_pk_bf16(v0[0], v0[1]); w.y = cvt_pk_bf16(v0[2], v0[3]); w.z = cvt_pk_bf16(v1[0], v1[1]); w.w = cvt_pk_bf16(v1[2], v1[3]);
                    *(u32x4*)(rowp + bj * HALF) = w; } }
    }
};

struct EpiResid {
    static constexpr bool PERM = false, AFTER_DRAIN = false;
    const float* base32; const bf16_t* base16; float* out; bf16_t* xb; float* ss;
    __device__ __forceinline__ void operator()(const f32x4 (&acc)[2][2][4][2], const Unit& u, int wr, int wc, int fr, int fq) const {
        const int col0 = u.pn * BM + wc * 32 + 4 * fq;
#pragma unroll
        for (int ai = 0; ai < 2; ++ai)
#pragma unroll
            for (int m = 0; m < 4; ++m) { const int row = u.pm * BM + ai * HALF + wr * 64 + m * 16 + fr; const size_t off = (size_t)row * DM + col0; float s = 0.f;
#pragma unroll
                for (int bj = 0; bj < 2; ++bj)
#pragma unroll
                    for (int n = 0; n < 2; ++n) { const size_t o2 = off + bj * HALF + n * 16; f32x4 bv;
                        if (base32) bv = *(const f32x4*)(base32 + o2);
                        else { const u32x2 bw = *(const u32x2*)(base16 + o2); bv[0] = __uint_as_float(bw.x << 16); bv[1] = __uint_as_float(bw.x & 0xffff0000u); bv[2] = __uint_as_float(bw.y << 16); bv[3] = __uint_as_float(bw.y & 0xffff0000u); }
                        const f32x4 v = bv + acc[ai][bj][m][n];
                        if (out) *(f32x4*)(out + o2) = v;
                        s += (v[0] * v[0] + v[1] * v[1]) + (v[2] * v[2] + v[3] * v[3]);
                        { u32x2 w; w.x = cvt_pk_bf16(v[0], v[1]); w.y = cvt_pk_bf16(v[2], v[3]); *(u32x2*)(xb + o2) = w; } }
                s += __shfl_xor(s, 16); s += __shfl_xor(s, 32);
                if (fq == 0) atomicAdd(ss + row, s);
                asm volatile("" ::: "memory"); }
    }
};

struct EpiCD {
    static constexpr bool PERM = false, AFTER_DRAIN = false;
    bf16_t* proj; const float* ss_in; float* ssq; float* sskv; float* lf; const float* b_f; const f32x2* rope;
    __device__ __forceinline__ void operator()(const f32x4 (&acc)[2][2][4][2], const Unit& u, int wr, int wc, int fr, int fq) const {
#pragma unroll
        for (int ai = 0; ai < 2; ++ai)
#pragma unroll
            for (int m = 0; m < 4; ++m) { const int row = u.pm * BM + ai * HALF + wr * 64 + m * 16 + fr; const float rs = rsqrtf(ss_in[row] * (1.0f / DM) + RMS_EPS); const int pos = row & (SEQ - 1);
#pragma unroll
                for (int bj = 0; bj < 2; ++bj) { const int cbase = u.pn * BM + bj * HALF + wc * 32;
                    f32x4 v0 = acc[ai][bj][m][0] * rs, v1 = acc[ai][bj][m][1] * rs;
                    if (cbase < Q_RANK + KV_RANK) {
                        float s = ((v0[0] * v0[0] + v0[1] * v0[1]) + (v0[2] * v0[2] + v0[3] * v0[3])) + ((v1[0] * v1[0] + v1[1] * v1[1]) + (v1[2] * v1[2] + v1[3] * v1[3]));
                        s += __shfl_xor(s, 16); s += __shfl_xor(s, 32);
                        if (fq == 0) atomicAdd((cbase < Q_RANK ? ssq : sskv) + row, s);
                    } else if (cbase == Q_RANK + KV_RANK) {
#pragma unroll
                        for (int e = 0; e < 4; ++e) { const f32x2 cs = rope[pos * 16 + 4 * fq + e]; const float x1 = v0[e], x2 = v1[e]; v0[e] = x1 * cs.x - x2 * cs.y; v1[e] = x2 * cs.x + x1 * cs.y; }
                    } else if (cbase == 2208) {
                        if (fq < 2) {
#pragma unroll
                            for (int e = 0; e < 4; ++e) { const int h = 4 * fq + e; const float z = v0[e] + b_f[h]; const float ls = -(fmaxf(-z, 0.f) + logf(1.0f + expf(-fabsf(z)))); lf[(size_t)row * 8 + h] = ls * LOG2E; }
                        }
                    }
                    if (cbase < 2208) { bf16_t* p = proj + (size_t)row * CD_PAD + cbase + 4 * fq;
                        u32x2 w0, w1; w0.x = cvt_pk_bf16(v0[0], v0[1]); w0.y = cvt_pk_bf16(v0[2], v0[3]); w1.x = cvt_pk_bf16(v1[0], v1[1]); w1.y = cvt_pk_bf16(v1[2], v1[3]);
                        *(u32x2*)p = w0; *(u32x2*)(p + 16) = w1; } }
                asm volatile("" ::: "memory"); }
    }
};

struct EpiQ {
    static constexpr bool PERM = false, AFTER_DRAIN = false;
    bf16_t* qc; const float* ssq; const f32x2* rope;
    __device__ __forceinline__ void operator()(const f32x4 (&acc)[2][2][4][2], const Unit& u, int wr, int wc, int fr, int fq) const {
#pragma unroll
        for (int ai = 0; ai < 2; ++ai)
#pragma unroll
            for (int m = 0; m < 4; ++m) { const int row = u.pm * BM + ai * HALF + wr * 64 + m * 16 + fr; const float rs = rsqrtf(ssq[row] * (1.0f / Q_RANK) + RMS_EPS); const int pos = row & (SEQ - 1);
#pragma unroll
                for (int bj = 0; bj < 2; ++bj) { const int cbase = u.pn * BM + bj * HALF + wc * 32;
                    f32x4 v0 = acc[ai][bj][m][0] * rs, v1 = acc[ai][bj][m][1] * rs;
                    if (((cbase >> 5) % 3) == 2) {
#pragma unroll
                        for (int e = 0; e < 4; ++e) { const f32x2 cs = rope[pos * 16 + 4 * fq + e]; const float x1 = v0[e], x2 = v1[e]; v0[e] = x1 * cs.x - x2 * cs.y; v1[e] = x2 * cs.x + x1 * cs.y; }
                    }
                    bf16_t* p = qc + (size_t)row * QC_COLS + cbase + 4 * fq;
                    u32x2 w0, w1; w0.x = cvt_pk_bf16(v0[0], v0[1]); w0.y = cvt_pk_bf16(v0[2], v0[3]); w1.x = cvt_pk_bf16(v1[0], v1[1]); w1.y = cvt_pk_bf16(v1[2], v1[3]);
                    *(u32x2*)p = w0; *(u32x2*)(p + 16) = w1; }
                asm volatile("" ::: "memory"); }
    }
};

template <int CTRL> __device__ __forceinline__ float dpp_row_ror(float v) { return __int_as_float(__builtin_amdgcn_update_dpp(0, __float_as_int(v), CTRL, 0xF, 0xF, false)); }
struct EpiGU {
    static constexpr bool PERM = false, AFTER_DRAIN = false;
    bf16_t* Y; const float* ss; const float* cw; const float* cb; float* gf; float* uf; float* gl;
    __device__ __forceinline__ void operator()(const f32x4 (&acc)[2][2][4][2], const Unit& u, int wr, int wc, int fr, int fq) const {
#pragma unroll
        for (int ai = 0; ai < 2; ++ai) {
            const int grp = u.pm * 4 + ai * 2 + wr, rowg = grp * 64;
            float rs[4];
#pragma unroll
            for (int m = 0; m < 4; ++m) rs[m] = rsqrtf(ss[rowg + 16 * m + fr] * (1.0f / DM) + RMS_EPS);
#pragma unroll
            for (int n = 0; n < 2; ++n) {
                const int c = u.pn * HALF + wc * 32 + n * 16 + 4 * fq;
                const f32x4 w0 = *(const f32x4*)(cw + c), w1 = *(const f32x4*)(cw + FF + c), w2 = *(const f32x4*)(cw + 2 * FF + c), bb = *(const f32x4*)(cb + c);
                f32x4 pr1 = {0.f, 0.f, 0.f, 0.f}, pr2 = {0.f, 0.f, 0.f, 0.f};
#pragma unroll
                for (int m = 0; m < 4; ++m) {
                    const f32x4 g0 = acc[ai][0][m][n] * rs[m], u0 = acc[ai][1][m][n] * rs[m];
                    f32x4 r1, r2;
#pragma unroll
                    for (int e2 = 0; e2 < 4; ++e2) { r1[e2] = dpp_row_ror<0x121>(g0[e2]); r2[e2] = dpp_row_ror<0x122>(g0[e2]); }
                    const f32x4 g1 = (fr >= 1) ? r1 : pr1, g2 = (fr >= 2) ? r2 : pr2;
                    pr1 = r1; pr2 = r2;
                    const f32x4 xg = w0 * g2 + w1 * g1 + w2 * g0 + bb; f32x4 y;
#pragma unroll
                    for (int e2 = 0; e2 < 4; ++e2) y[e2] = xg[e2] * __builtin_amdgcn_rcpf(1.0f + __expf(-xg[e2])) * u0[e2];
                    const int row = rowg + 16 * m + fr;
                    if (m > 0 || fr >= 2) { u32x2 w; w.x = cvt_pk_bf16(y[0], y[1]); w.y = cvt_pk_bf16(y[2], y[3]); *(u32x2*)(Y + (size_t)row * FF + c) = w; }
                    if (m == 0) { if (fr < 2) { *(f32x4*)(gf + (size_t)(grp * 2 + fr) * FF + c) = g0; *(f32x4*)(uf + (size_t)(grp * 2 + fr) * FF + c) = u0; } }
                    if (m == 3) { if (fr >= 14) *(f32x4*)(gl + (size_t)(grp * 2 + fr - 14) * FF + c) = g0; }
                }
            }
            asm volatile("" ::: "memory");
        }
    }
};

template <class Epi, class Sched, bool ALIGN_EPI = false, bool SP2 = false>
__device__ __forceinline__ void gemm_phase(PG8_LAS unsigned char* lds, const Gemm g, const Sched& S, const Epi& E) {
    int tid_ = threadIdx.x; asm volatile("" : "+v"(tid_)); const int tid = tid_, wid = __builtin_amdgcn_readfirstlane(tid >> 6), lane = tid & 63, wr = wid >> 2, wc = wid & 3, fr = lane & 15, fq = lane >> 4;
    int K_ = g.K; asm volatile("" : "+s"(K_)); const int K = K_, nt = K / BK;
    unsigned voffA[2], voffB[2];
#pragma unroll
    for (int i = 0; i < 2; ++i) { int R, C; stage_rc(tid * 16 + i * 8192, R, C); const int Rb = Epi::PERM ? ((R & ~31) + perm32(R & 31)) : R;
        voffA[i] = (unsigned)(R * g.lda + C) * 2u; voffB[i] = (unsigned)(Rb * K + C) * 2u; }
    const size_t kstep = (size_t)(BK * 2);
    const size_t hstepB = (size_t)HALF * K * 2, hstepA = (size_t)HALF * g.lda * 2;
    const size_t tstepA = 2 * hstepA, tstepB = 2 * hstepB;
    const unsigned ldsw = (unsigned)wid * 1024u;
    const int aoff = lds_byte(wr * 64 + fr, fq * 8), boff = lds_byte(wc * 32 + fr, fq * 8);
#define PG8_SA(b, h) (((b) * 2 + (h)) * HTB)
#define PG8_SB(b, h) ((4 + (b) * 2 + (h)) * HTB)
#define PG8_STAGE(bufoff, gbase, voff) do { _Pragma("unroll") for (int _i = 0; _i < 2; ++_i) \
        __builtin_amdgcn_global_load_lds((const unsigned*)((const char*)(gbase) + (voff)[_i]), (PG8_LAS unsigned*)(lds + (bufoff) + ldsw + _i * 8192), 16, 0, 0); } while (0)
#define PG8_LDA(dst, b, h) do { _Pragma("unroll") for (int m = 0; m < 4; ++m) _Pragma("unroll") for (int k = 0; k < 2; ++k) dst[m][k] = *(const PG8_LAS bf16x8*)(lds + PG8_SA(b, h) + aoff + m * 2048 + k * 1024); } while (0)
#define PG8_LDB(dst, b, h) do { _Pragma("unroll") for (int n = 0; n < 2; ++n) _Pragma("unroll") for (int k = 0; k < 2; ++k) dst[n][k] = *(const PG8_LAS bf16x8*)(lds + PG8_SB(b, h) + boff + n * 2048 + k * 1024); } while (0)
#define PG8_MMA(ai, bj, At, Bt) do { __builtin_amdgcn_s_setprio(1); _Pragma("unroll") for (int m = 0; m < 4; ++m) _Pragma("unroll") for (int n = 0; n < 2; ++n) _Pragma("unroll") for (int k = 0; k < 2; ++k) \
        acc[ai][bj][m][n] = __builtin_amdgcn_mfma_f32_16x16x32_bf16(Bt[n][k], At[m][k], acc[ai][bj][m][n], 0, 0, 0); __builtin_amdgcn_s_setprio(0); } while (0)
#define PG8_WAIT_V(n) asm volatile("s_waitcnt vmcnt(" #n ")" ::: "memory")
#define PG8_WAIT_L(n) asm volatile("s_waitcnt lgkmcnt(" #n ")" ::: "memory")
#define PG8_BAR __builtin_amdgcn_s_barrier()
#define PG8_SCHED __builtin_amdgcn_sched_barrier(0)
    Unit cur, nxt; int ui = 0;
    if (!S.next(0, cur)) return;
    f32x4 acc[2][2][4][2];
#pragma unroll
    for (int a = 0; a < 2; ++a)
#pragma unroll
        for (int b = 0; b < 2; ++b)
#pragma unroll
            for (int m = 0; m < 4; ++m)
#pragma unroll
                for (int n = 0; n < 2; ++n) acc[a][b][m][n] = (f32x4){0.f, 0.f, 0.f, 0.f};
    bf16x8 At[4][2], B0[2][2], B1[2][2];
    const char* cA = (const char*)g.A + (size_t)cur.pm * tstepA; const char* cB = (const char*)g.Bt + (size_t)cur.pn * tstepB;
    S.a_ready(cur);
    if constexpr (SP2) {
        PG8_STAGE(PG8_SB(0, 0), cB, voffB); PG8_STAGE(PG8_SB(0, 1), cB + hstepB, voffB); PG8_STAGE(PG8_SA(0, 0), cA, voffA); PG8_STAGE(PG8_SA(0, 1), cA + hstepA, voffA);
        if (wr == 1) PG8_BAR;
        PG8_WAIT_V(2); PG8_BAR;
        PG8_STAGE(PG8_SB(1, 0), cB + kstep, voffB); PG8_STAGE(PG8_SA(1, 0), cA + kstep, voffA); PG8_STAGE(PG8_SB(1, 1), cB + hstepB + kstep, voffB);
        PG8_WAIT_V(6); PG8_BAR;
    } else {
        PG8_STAGE(PG8_SB(0, 0), cB, voffB); PG8_STAGE(PG8_SA(0, 0), cA, voffA); PG8_STAGE(PG8_SB(0, 1), cB + hstepB, voffB); PG8_STAGE(PG8_SA(0, 1), cA + hstepA, voffA);
        if (wr == 1) PG8_BAR;
        PG8_WAIT_V(4); PG8_BAR;
        PG8_STAGE(PG8_SB(1, 0), cB + kstep, voffB); PG8_STAGE(PG8_SA(1, 0), cA + kstep, voffA); PG8_STAGE(PG8_SB(1, 1), cB + hstepB + kstep, voffB);
        PG8_WAIT_V(6); PG8_BAR;
    }
    for (;;) {
        const bool has_next = S.next(ui + 1, nxt);
        const char* nA = has_next ? (const char*)g.A + (size_t)nxt.pm * tstepA : cA; const char* nB = has_next ? (const char*)g.Bt + (size_t)nxt.pn * tstepB : cB;
        for (int t = 0; t < nt; t += 2) {
            const bool last = (t == nt - 2);
            const char* a1 = cA + (size_t)(t + 1) * kstep;
            const char* a2 = last ? nA : cA + (size_t)(t + 2) * kstep; const char* b2 = last ? nB : cB + (size_t)(t + 2) * kstep;
            const char* a3 = a2 + kstep; const char* b3 = b2 + kstep;
            if (last && has_next) S.a_ready(nxt);
            if constexpr (SP2) {
            PG8_LDB(B0, 0, 0); PG8_LDB(B1, 0, 1); PG8_SCHED; PG8_LDA(At, 0, 0); PG8_STAGE(PG8_SA(1, 1), a1 + hstepA, voffA);
            PG8_WAIT_V(8); PG8_WAIT_L(0); PG8_BAR; PG8_MMA(0, 0, At, B0); PG8_MMA(0, 1, At, B1); PG8_BAR; PG8_SCHED;
            PG8_LDA(At, 0, 1); PG8_STAGE(PG8_SB(0, 0), b2, voffB); PG8_STAGE(PG8_SB(0, 1), b2 + hstepB, voffB); PG8_STAGE(PG8_SA(0, 0), a2, voffA);
            PG8_WAIT_V(8); PG8_WAIT_L(0); PG8_BAR; PG8_MMA(1, 0, At, B0); PG8_MMA(1, 1, At, B1); PG8_BAR; PG8_SCHED;
            PG8_LDB(B0, 1, 0); PG8_LDB(B1, 1, 1); PG8_SCHED; PG8_LDA(At, 1, 0); PG8_STAGE(PG8_SA(0, 1), a2 + hstepA, voffA);
            PG8_WAIT_V(8); PG8_WAIT_L(0); PG8_BAR; PG8_MMA(0, 0, At, B0); PG8_MMA(0, 1, At, B1); PG8_BAR; PG8_SCHED;
            PG8_LDA(At, 1, 1); PG8_STAGE(PG8_SB(1, 0), b3, voffB); PG8_STAGE(PG8_SB(1, 1), b3 + hstepB, voffB); PG8_STAGE(PG8_SA(1, 0), a3, voffA);
            PG8_WAIT_V(8); PG8_WAIT_L(0); PG8_BAR; PG8_MMA(1, 0, At, B0); PG8_MMA(1, 1, At, B1); PG8_BAR; PG8_SCHED;
            } else {
            PG8_LDB(B0, 0, 0); PG8_SCHED; PG8_LDA(At, 0, 0); PG8_STAGE(PG8_SA(1, 1), a1 + hstepA, voffA);
            PG8_WAIT_L(8); PG8_BAR; PG8_WAIT_L(0); PG8_MMA(0, 0, At, B0); PG8_BAR; PG8_SCHED;
            PG8_LDB(B1, 0, 1); PG8_STAGE(PG8_SB(0, 0), b2, voffB);
            PG8_BAR; PG8_WAIT_L(0); PG8_MMA(0, 1, At, B1); PG8_BAR;
            PG8_LDA(At, 0, 1); PG8_STAGE(PG8_SA(0, 0), a2, voffA);
            PG8_BAR; PG8_WAIT_L(0); PG8_MMA(1, 0, At, B0); PG8_BAR; PG8_SCHED;
            PG8_STAGE(PG8_SB(0, 1), b2 + hstepB, voffB);
            PG8_WAIT_V(6); PG8_BAR; PG8_MMA(1, 1, At, B1); PG8_BAR;
            PG8_LDB(B0, 1, 0); PG8_SCHED; PG8_LDA(At, 1, 0); PG8_STAGE(PG8_SA(0, 1), a2 + hstepA, voffA);
            PG8_WAIT_L(8); PG8_BAR; PG8_WAIT_L(0); PG8_MMA(0, 0, At, B0); PG8_BAR; PG8_SCHED;
            PG8_LDB(B1, 1, 1); PG8_STAGE(PG8_SB(1, 0), b3, voffB);
            PG8_BAR; PG8_WAIT_L(0); PG8_MMA(0, 1, At, B1); PG8_BAR;
            PG8_LDA(At, 1, 1); PG8_STAGE(PG8_SA(1, 0), a3, voffA);
            PG8_BAR; PG8_WAIT_L(0); PG8_MMA(1, 0, At, B0); PG8_BAR; PG8_SCHED;
            PG8_STAGE(PG8_SB(1, 1), b3 + hstepB, voffB);
            PG8_WAIT_V(6); PG8_BAR; PG8_MMA(1, 1, At, B1); PG8_BAR;
            }
        }
        if constexpr (ALIGN_EPI) { if (wr == 0) PG8_BAR; }
        if constexpr (!Epi::AFTER_DRAIN) { E(acc, cur, wr, wc, fr, fq); S.done(cur); }
        if (!has_next) break;
#pragma unroll
        for (int a = 0; a < 2; ++a)
#pragma unroll
            for (int b = 0; b < 2; ++b)
#pragma unroll
                for (int m = 0; m < 4; ++m)
#pragma unroll
                    for (int n = 0; n < 2; ++n) acc[a][b][m][n] = (f32x4){0.f, 0.f, 0.f, 0.f};
        cur = nxt; cA = nA; cB = nB; ++ui;
        if constexpr (ALIGN_EPI) { if (wr == 1) PG8_BAR; }
    }
    PG8_WAIT_V(0);
    if constexpr (!ALIGN_EPI) { if (wr == 0) PG8_BAR; }
    PG8_BAR;
    if constexpr (Epi::AFTER_DRAIN) { E.fused(acc, cur, wr, wc, fr, fq, lds, wid, lane); S.done(cur); }
#undef PG8_SA
#undef PG8_SB
#undef PG8_STAGE
#undef PG8_LDA
#undef PG8_LDB
#undef PG8_MMA
#undef PG8_WAIT_V
#undef PG8_WAIT_L
#undef PG8_BAR
#undef PG8_SCHED
}
}
namespace att {
#define LAS3 __attribute__((address_space(3)))
typedef unsigned short bf16_t;
typedef short bf16x8 __attribute__((ext_vector_type(8)));
typedef short s16x4 __attribute__((ext_vector_type(4)));
typedef float f32x16 __attribute__((ext_vector_type(16)));
typedef float f32x4 __attribute__((ext_vector_type(4)));
typedef unsigned u32x4 __attribute__((ext_vector_type(4)));
typedef unsigned u32x2 __attribute__((ext_vector_type(2)));
constexpr int KBUF = 13312, VBUF = 8192, FBUF = 256, BUFB = KBUF + VBUF + FBUF;
constexpr int TB_OFF = 3 * BUFB, QIDX_OFF = TB_OFF + 1040, FLAG_OFF = QIDX_OFF + 16, ATT_LDS = FLAG_OFF + 16;
constexpr float NEG_BIG = -1.0e30f;

typedef float f32x2_t __attribute__((ext_vector_type(2))); typedef __bf16 bf16x2_t __attribute__((ext_vector_type(2)));
__device__ __forceinline__ unsigned pk2(float lo, float hi) { f32x2_t v = {lo, hi}; bf16x2_t b = __builtin_convertvector(v, bf16x2_t); return __builtin_bit_cast(unsigned, b); }
__device__ __forceinline__ float lane32_other(float v) {
    auto rr = __builtin_amdgcn_permlane32_swap(__float_as_uint(v), __float_as_uint(v), false, false);
    return (__lane_id() & 32) ? __uint_as_float(rr[0]) : __uint_as_float(rr[1]);
}
__device__ __forceinline__ float lane32_max(float v) { auto rr = __builtin_amdgcn_permlane32_swap(__float_as_uint(v), __float_as_uint(v), false, false); return fmaxf(__uint_as_float(rr[0]), __uint_as_float(rr[1])); }
__device__ __forceinline__ float lane32_sum(float v) { auto rr = __builtin_amdgcn_permlane32_swap(__float_as_uint(v), __float_as_uint(v), false, false); return __uint_as_float(rr[0]) + __uint_as_float(rr[1]); }
__device__ __forceinline__ s16x4 vtr(const LAS3 unsigned char* p) { typedef short v4i16_t __attribute__((ext_vector_type(4))); return __builtin_bit_cast(s16x4, __builtin_amdgcn_ds_read_tr16_b64_v4i16((LAS3 v4i16_t*)p)); }

struct Ptrs {
    const bf16_t* Q; int qp, qh;
    const bf16_t* K; int kp, kh;
    const bf16_t* K2; int k2p;
    const bf16_t* V; int vp, vh;
    bf16_t* O; int oc;
    const float* bias;
    const float* kmax;
};

template <int VAR>
__device__ __forceinline__ void attn_unit(const Ptrs& P, int b, int h, int qb, LAS3 unsigned char* lds) {
    constexpr int DQ = (VAR == 2) ? 96 : 64, ND = DQ / 16, KP = DQ * 2 + 16;
    constexpr bool DESC = (VAR == 1 || VAR == 3);
    int tid_ = threadIdx.x; asm volatile("" : "+v"(tid_)); const int tid = tid_, lane = tid & 63, r32 = lane & 31, hi = lane >> 5; const int wid = __builtin_amdgcn_readfirstlane(tid >> 6);
    const size_t rowbase = (size_t)b * SEQ; const int q0 = qb * 256, qrow = q0 + wid * 32 + r32;
    const int cw = 4 * qb + (wid >> 1);
    const int t_hi = 4 * qb + 3, t_lo = (VAR == 0) ? ((4 * qb - 8) > 0 ? (4 * qb - 8) : 0) : 0, nt = t_hi - t_lo + 1;
    const int w_lo = (VAR == 0) ? ((cw - 8) > 0 ? (cw - 8) : 0) : 0, w_hi = cw;
    LAS3 float* TB = (LAS3 float*)(lds + TB_OFF);
    if (VAR == 0) { for (int i = tid; i < 257; i += 512) TB[i] = P.bias[h * 257 + i] * LOG2E; }
    volatile LAS3 unsigned* donec = (volatile LAS3 unsigned*)(lds + FLAG_OFF);
    bool wdone = false; int dp = 0;
    if (DESC) { if (tid == 0) donec[0] = 0u; }
    bf16x8 qf[ND];
    { const bf16_t* qp = P.Q + (rowbase + qrow) * P.qp + h * P.qh + hi * 8;
#pragma unroll
      for (int d0 = 0; d0 < ND; ++d0) qf[d0] = *(const bf16x8*)(qp + d0 * 16); }
    float qk_bound = 0.f;
    if (VAR == 3) { float s2_ = 0.f;
#pragma unroll
        for (int d0 = 0; d0 < ND; ++d0)
#pragma unroll
            for (int e = 0; e < 8; ++e) { const float v_ = __uint_as_float(((unsigned)(unsigned short)qf[d0][e]) << 16); s2_ += v_ * v_; }
        s2_ = lane32_sum(s2_); qk_bound = sqrtf(s2_) * P.kmax[b * 8 + h] * 1.001f; }
    const int lkey = tid >> 3, lj = tid & 7;
    const bf16_t* kg = P.K + (rowbase + lkey) * P.kp + h * P.kh + lj * 8;
    const bf16_t* vg = P.V + (rowbase + lkey) * P.vp + h * P.vh + lj * 8;
    const bf16_t* k2g = (VAR == 2) ? P.K2 + (rowbase + (tid >> 2)) * P.k2p + (tid & 3) * 8 : nullptr;
    const float* fg = (VAR == 3) ? P.bias + ((size_t)(b * 8 + h)) * SEQ + (tid & 15) * 4 : nullptr;
    const int kw = lkey * KP + lj * 16, vw = KBUF + (lj >> 2) * 4096 + lkey * 64 + (lj & 3) * 16, k2w = (tid >> 2) * KP + 128 + (tid & 3) * 16, fw = KBUF + VBUF + (tid & 15) * 16;
    u32x4 rk, rv, rk2; f32x4 rf;
#define ATT_LOAD(t) do { const size_t ko_ = (size_t)(t) * 64; rk = *(const u32x4*)(kg + ko_ * P.kp); rv = *(const u32x4*)(vg + ko_ * P.vp); \
        if (VAR == 2) { if (tid < 256) rk2 = *(const u32x4*)(k2g + ko_ * P.k2p); } if (VAR == 3) { if (tid < 16) rf = *(const f32x4*)(fg + ko_); } } while (0)
#define ATT_STORE(bufo) do { *(LAS3 u32x4*)(lds + (bufo) + kw) = rk; *(LAS3 u32x4*)(lds + (bufo) + vw) = rv; \
        if (VAR == 2) { if (tid < 256) *(LAS3 u32x4*)(lds + (bufo) + k2w) = rk2; } if (VAR == 3) { if (tid < 16) *(LAS3 f32x4*)(lds + (bufo) + fw) = rf; } } while (0)
    const int pi = (r32 & ~12) | ((r32 & 4) << 1) | ((r32 & 8) >> 1);
    const int ka = pi * KP + hi * 16;
    const int va = KBUF + (8 * hi + ((lane & 15) >> 2)) * 64 + (16 * ((lane >> 4) & 1) + 4 * (lane & 3)) * 2;
    float m_run = NEG_BIG, l_run = 0.f, R = 0.f;
    f32x16 ot0 = {}, ot1 = {};
    { const int t0 = DESC ? t_hi : t_lo; ATT_LOAD(t0); ATT_STORE(0); }
    __syncthreads();
    for (int it = 0; it < nt; ++it) {
        const int t = DESC ? (t_hi - it) : (t_lo + it);
        const int bufo = (it & 1) * BUFB, nbufo = BUFB - bufo;
        const bool more = (it + 1 < nt);
        if (more) { const int tn = DESC ? (t - 1) : (t + 1); ATT_LOAD(tn); }
        if (DESC) { if (tid == 0) donec[dp == 2 ? 0 : dp + 1] = 0u; }
        if (t >= w_lo && t <= w_hi && !(DESC && wdone)) {
            f32x16 sa = {}, sb = {};
            const LAS3 unsigned char* kb = lds + bufo + ka;
#pragma unroll
            for (int d0 = 0; d0 < ND; ++d0) {
                const bf16x8 k0 = *(const LAS3 bf16x8*)(kb + d0 * 32), k1 = *(const LAS3 bf16x8*)(kb + 32 * KP + d0 * 32);
                sa = __builtin_amdgcn_mfma_f32_32x32x16_bf16(k0, qf[d0], sa, 0, 0, 0);
                sb = __builtin_amdgcn_mfma_f32_32x32x16_bf16(k1, qf[d0], sb, 0, 0, 0);
            }
            bf16x8 pk[4];
            if (VAR != 1) {
                if (VAR == 0) {
                    if (cw - t >= 3) { const float c = TB[256];
#pragma unroll
                        for (int r = 0; r < 16; ++r) { sa[r] += c; sb[r] += c; } }
                    else { const int d0_ = qrow - 64 * t - 8 * hi + 128;
#pragma unroll
                        for (int r = 0; r < 16; ++r) { int ia = d0_ - 16 * (r >> 3) - (r & 7), ib = ia - 32; ia = ia < 0 ? 0 : (ia > 256 ? 256 : ia); ib = ib < 0 ? 0 : (ib > 256 ? 256 : ib);
                            sa[r] += TB[ia]; sb[r] += TB[ib]; } }
                }
                if (VAR == 3) {
                    const LAS3 float* F = (const LAS3 float*)(lds + bufo + KBUF + VBUF) + 8 * hi;
#pragma unroll
                    for (int a = 0; a < 2; ++a) {
                        const f32x4 fa0 = *(const LAS3 f32x4*)(F + 16 * a), fa1 = *(const LAS3 f32x4*)(F + 16 * a + 4), fb0 = *(const LAS3 f32x4*)(F + 32 + 16 * a), fb1 = *(const LAS3 f32x4*)(F + 32 + 16 * a + 4);
#pragma unroll
                        for (int e = 0; e < 4; ++e) { sa[8 * a + e] -= fa0[e]; sa[8 * a + 4 + e] -= fa1[e]; sb[8 * a + e] -= fb0[e]; sb[8 * a + 4 + e] -= fb1[e]; }
                    }
                    if (t == cw) { const int lim = qrow - 64 * t - 8 * hi;
#pragma unroll
                        for (int r = 0; r < 16; ++r) { const int kk = 16 * (r >> 3) + (r & 7); if (kk > lim) sa[r] = NEG_BIG; if (kk + 32 > lim) sb[r] = NEG_BIG; } }
                }
                float mx = fmaxf(sa[0], sb[0]);
#pragma unroll
                for (int r = 1; r < 16; ++r) mx = fmaxf(mx, fmaxf(sa[r], sb[r]));
                mx = lane32_max(mx);
                const float m_new = fmaxf(m_run, mx), alpha = __builtin_amdgcn_exp2f(m_run - m_new); m_run = m_new;
                float ls = 0.f;
#pragma unroll
                for (int r = 0; r < 16; ++r) { sa[r] = __builtin_amdgcn_exp2f(sa[r] - m_new); sb[r] = __builtin_amdgcn_exp2f(sb[r] - m_new); ls += sa[r] + sb[r]; }
                l_run = l_run * alpha + ls;
#pragma unroll
                for (int r = 0; r < 16; ++r) { ot0[r] *= alpha; ot1[r] *= alpha; }
                if (VAR == 3) {
                    const float f0_ = *((const LAS3 float*)(lds + bufo + KBUF + VBUF));
                    if (__all(qk_bound - f0_ - m_run < -160.0f) || t == 0) wdone = true;
                }
            } else {
                const int lim = (t == cw) ? (qrow - 64 * t - 8 * hi) : 1000;
                float seg[4];
#pragma unroll
                for (int a = 0; a < 4; ++a) { float run = 0.f;
#pragma unroll
                    for (int j = 7; j >= 0; --j) { const int r = 8 * (a & 1) + j; const float z = (a < 2) ? sa[r] : sb[r]; const int kk = 16 * a + j;
                        const float sp = fmaxf(z, 0.f) + __logf(1.0f + __expf(-fabsf(z)));
                        const bool vis = kk < lim;
                        const float lb = z - sp + run;
                        if (a < 2) sa[r] = vis ? lb : NEG_BIG; else sb[r] = vis ? lb : NEG_BIG;
                        run += vis ? -sp : 0.f; }
                    seg[a] = run; }
                float oth[4];
#pragma unroll
                for (int a = 0; a < 4; ++a) oth[a] = lane32_other(seg[a]);
                float off[4]; float accu = R;
#pragma unroll
                for (int a = 3; a >= 0; --a) { if (hi) { off[a] = accu; accu += seg[a] + oth[a]; } else { off[a] = accu + oth[a]; accu += seg[a] + oth[a]; } }
                R = accu;
                if (__all(R < -105.0f) || t == 0) wdone = true;
#pragma unroll
                for (int r = 0; r < 8; ++r) { sa[r] = __expf(sa[r] + off[0]); sa[8 + r] = __expf(sa[8 + r] + off[1]); sb[r] = __expf(sb[r] + off[2]); sb[8 + r] = __expf(sb[8 + r] + off[3]); }
            }
            { u32x4 w;
              w.x = pk2(sa[0], sa[1]); w.y = pk2(sa[2], sa[3]); w.z = pk2(sa[4], sa[5]); w.w = pk2(sa[6], sa[7]); pk[0] = __builtin_bit_cast(bf16x8, w);
              w.x = pk2(sa[8], sa[9]); w.y = pk2(sa[10], sa[11]); w.z = pk2(sa[12], sa[13]); w.w = pk2(sa[14], sa[15]); pk[1] = __builtin_bit_cast(bf16x8, w);
              w.x = pk2(sb[0], sb[1]); w.y = pk2(sb[2], sb[3]); w.z = pk2(sb[4], sb[5]); w.w = pk2(sb[6], sb[7]); pk[2] = __builtin_bit_cast(bf16x8, w);
              w.x = pk2(sb[8], sb[9]); w.y = pk2(sb[10], sb[11]); w.z = pk2(sb[12], sb[13]); w.w = pk2(sb[14], sb[15]); pk[3] = __builtin_bit_cast(bf16x8, w); }
            const LAS3 unsigned char* vb = lds + bufo + va;
#pragma unroll
            for (int s = 0; s < 4; ++s) {
                const s16x4 a0 = vtr(vb + s * 1024), a1 = vtr(vb + s * 1024 + 256), c0 = vtr(vb + 4096 + s * 1024), c1 = vtr(vb + 4096 + s * 1024 + 256);
                const bf16x8 v0 = {a0[0], a0[1], a0[2], a0[3], a1[0], a1[1], a1[2], a1[3]}, v1 = {c0[0], c0[1], c0[2], c0[3], c1[0], c1[1], c1[2], c1[3]};
                ot0 = __builtin_amdgcn_mfma_f32_32x32x16_bf16(v0, pk[s], ot0, 0, 0, 0);
                ot1 = __builtin_amdgcn_mfma_f32_32x32x16_bf16(v1, pk[s], ot1, 0, 0, 0);
            }
        }
        if (more) ATT_STORE(nbufo);
        if (DESC) { if (wdone && lane == 0) __hip_atomic_fetch_add((LAS3 unsigned*)(lds + FLAG_OFF) + dp, 1u, __ATOMIC_RELAXED, __HIP_MEMORY_SCOPE_WORKGROUP); }
        __syncthreads();
        if (DESC) { if (donec[dp] == 8u) break; dp = (dp == 2) ? 0 : dp + 1; }
    }
#undef ATT_LOAD
#undef ATT_STORE
    float inv = 1.f;
    if (VAR != 1) { const float lt = lane32_sum(l_run); inv = 1.0f / lt; }
    bf16_t* op = P.O + (rowbase + qrow) * DM + P.oc + h * 64 + 4 * hi;
#pragma unroll
    for (int a = 0; a < 4; ++a) {
        u32x2 w0, w1; w0.x = pk2(ot0[4 * a] * inv, ot0[4 * a + 1] * inv); w0.y = pk2(ot0[4 * a + 2] * inv, ot0[4 * a + 3] * inv);
        w1.x = pk2(ot1[4 * a] * inv, ot1[4 * a + 1] * inv); w1.y = pk2(ot1[4 * a + 2] * inv, ot1[4 * a + 3] * inv);
        *(u32x2*)(op + 8 * a) = w0; *(u32x2*)(op + 32 + 8 * a) = w1;
    }
}

template <int VAR>
__device__ __forceinline__ void attn_unit_sm(const Ptrs& P, int b, int h, int qb, LAS3 unsigned char* lds) {
    constexpr int DQ = (VAR == 2) ? 96 : 64, ND = DQ / 16, KP = DQ * 2 + 16;
    int tid_ = threadIdx.x; asm volatile("" : "+v"(tid_)); const int tid = tid_, lane = tid & 63, r32 = lane & 31, hi = lane >> 5; const int wid = __builtin_amdgcn_readfirstlane(tid >> 6);
    const size_t rowbase = (size_t)b * SEQ; const int q0 = qb * 256, qrow = q0 + wid * 32 + r32;
    const int cw = 4 * qb + (wid >> 1);
    const int t_hi = 4 * qb + 3, t_lo = (VAR == 0) ? ((4 * qb - 8) > 0 ? (4 * qb - 8) : 0) : 0, nt = t_hi - t_lo + 1;
    const int w_lo = (VAR == 0) ? ((cw - 8) > 0 ? (cw - 8) : 0) : 0, w_hi = cw;
    LAS3 float* TB = (LAS3 float*)(lds + TB_OFF);
    if (VAR == 0) { for (int i = tid; i < 257; i += 512) TB[i] = P.bias[h * 257 + i] * LOG2E; }
    bf16x8 qf[ND];
    { const bf16_t* qp = P.Q + (rowbase + qrow) * P.qp + h * P.qh + hi * 8;
#pragma unroll
      for (int d0 = 0; d0 < ND; ++d0) qf[d0] = *(const bf16x8*)(qp + d0 * 16); }
    const float cbase = (VAR == 3) ? P.bias[((size_t)(b * 8 + h)) * SEQ + qrow] : 0.f;
    const int lkey = tid >> 3, lj = tid & 7;
    const bf16_t* kg = P.K + (rowbase + lkey) * P.kp + h * P.kh + lj * 8;
    const bf16_t* vg = P.V + (rowbase + lkey) * P.vp + h * P.vh + lj * 8;
    const bf16_t* k2g = (VAR == 2) ? P.K2 + (rowbase + (tid >> 2)) * P.k2p + (tid & 3) * 8 : nullptr;
    const float* fg = (VAR == 3) ? P.bias + ((size_t)(b * 8 + h)) * SEQ + (tid & 15) * 4 : nullptr;
    const int kw = lkey * KP + lj * 16, vw = KBUF + (lj >> 2) * 4096 + lkey * 64 + (lj & 3) * 16, k2w = (tid >> 2) * KP + 128 + (tid & 3) * 16, fw = KBUF + VBUF + (tid & 15) * 16;
    u32x4 rk0, rv0, rk20, rk1, rv1, rk21; f32x4 rf0, rf1;
#define ATT_LOAD(t, S) do { const size_t ko_ = (size_t)(t) * 64; rk##S = *(const u32x4*)(kg + ko_ * P.kp); rv##S = *(const u32x4*)(vg + ko_ * P.vp); \
        if (VAR == 2) { if (tid < 256) rk2##S = *(const u32x4*)(k2g + ko_ * P.k2p); } if (VAR == 3) { if (tid < 16) rf##S = *(const f32x4*)(fg + ko_); } } while (0)
#define ATT_STORE(bufo, S) do { *(LAS3 u32x4*)(lds + (bufo) + kw) = rk##S; *(LAS3 u32x4*)(lds + (bufo) + vw) = rv##S; \
        if (VAR == 2) { if (tid < 256) *(LAS3 u32x4*)(lds + (bufo) + k2w) = rk2##S; } if (VAR == 3) { if (tid < 16) *(LAS3 f32x4*)(lds + (bufo) + fw) = rf##S; } } while (0)
    const int pi = (r32 & ~12) | ((r32 & 4) << 1) | ((r32 & 8) >> 1);
    const int ka = pi * KP + hi * 16;
    const int va = KBUF + (8 * hi + ((lane & 15) >> 2)) * 64 + (16 * ((lane >> 4) & 1) + 4 * (lane & 3)) * 2;
    float m_run = 0.f, l_run = 0.f;
    f32x16 ot0 = {}, ot1 = {}, negm;
#pragma unroll
    for (int r = 0; r < 16; ++r) negm[r] = cbase;
    asm volatile("" : "+v"(negm));
    f32x16 sA0 = {}, sA1 = {}, sB0 = {}, sB1 = {};
#define SM_QK(SA, SB, kbo) do { const LAS3 unsigned char* kb_ = lds + (kbo) + ka; \
        _Pragma("unroll") for (int d0 = 0; d0 < ND; ++d0) { \
            const bf16x8 k0_ = *(const LAS3 bf16x8*)(kb_ + d0 * 32), k1_ = *(const LAS3 bf16x8*)(kb_ + 32 * KP + d0 * 32); \
            if (d0 == 0) { SA = __builtin_amdgcn_mfma_f32_32x32x16_bf16(k0_, qf[0], negm, 0, 0, 0); SB = __builtin_amdgcn_mfma_f32_32x32x16_bf16(k1_, qf[0], negm, 0, 0, 0); } \
            else { SA = __builtin_amdgcn_mfma_f32_32x32x16_bf16(k0_, qf[d0], SA, 0, 0, 0); SB = __builtin_amdgcn_mfma_f32_32x32x16_bf16(k1_, qf[d0], SB, 0, 0, 0); } } } while (0)
#define SM_BIAS(SA, SB, tn, bo) do { \
        if (VAR == 0) { \
            if (cw - (tn) >= 3) { const float c_ = TB[256]; _Pragma("unroll") for (int r = 0; r < 16; ++r) { SA[r] += c_; SB[r] += c_; } } \
            else { const int d0_ = qrow - 64 * (tn) - 8 * hi + 128; \
                _Pragma("unroll") for (int r = 0; r < 16; ++r) { int ia = d0_ - 16 * (r >> 3) - (r & 7), ib = ia - 32; ia = ia < 0 ? 0 : (ia > 256 ? 256 : ia); ib = ib < 0 ? 0 : (ib > 256 ? 256 : ib); \
                    SA[r] += TB[ia]; SB[r] += TB[ib]; } } } \
        if (VAR == 3) { const LAS3 float* F_ = (const LAS3 float*)(lds + (bo) + KBUF + VBUF) + 8 * hi; \
            _Pragma("unroll") for (int a = 0; a < 2; ++a) { \
                const f32x4 fa0 = *(const LAS3 f32x4*)(F_ + 16 * a), fa1 = *(const LAS3 f32x4*)(F_ + 16 * a + 4), fb0 = *(const LAS3 f32x4*)(F_ + 32 + 16 * a), fb1 = *(const LAS3 f32x4*)(F_ + 32 + 16 * a + 4); \
                _Pragma("unroll") for (int e = 0; e < 4; ++e) { SA[8 * a + e] -= fa0[e]; SA[8 * a + 4 + e] -= fa1[e]; SB[8 * a + e] -= fb0[e]; SB[8 * a + 4 + e] -= fb1[e]; } } \
            if ((tn) >= cw) { const int lim_ = qrow - 64 * (tn) - 8 * hi; \
                _Pragma("unroll") for (int r = 0; r < 16; ++r) { const int kk = 16 * (r >> 3) + (r & 7); if (kk > lim_) SA[r] = NEG_BIG; if (kk + 32 > lim_) SB[r] = NEG_BIG; } } } } while (0)
#define SM_BIAS_C(SA, SB, tn) do { if (VAR == 2) { if ((tn) > cw) { _Pragma("unroll") for (int r = 0; r < 16; ++r) { SA[r] = NEG_BIG; SB[r] = NEG_BIG; } } } } while (0)
#define SM_REF(SA, SB, HASN, NA, NB) do { \
        float mx_ = fmaxf(SA[0], SB[0]); _Pragma("unroll") for (int r = 1; r < 16; ++r) mx_ = fmaxf(mx_, fmaxf(SA[r], SB[r])); \
        mx_ = lane32_max(mx_); \
        if (__any(mx_ > 8.0f)) { const float dl_ = fmaxf(mx_, 0.f); m_run += dl_; \
            _Pragma("unroll") for (int r = 0; r < 16; ++r) { SA[r] -= dl_; SB[r] -= dl_; } \
            if (HASN) { _Pragma("unroll") for (int r = 0; r < 16; ++r) { NA[r] -= dl_; NB[r] -= dl_; } } \
            const float nm_ = cbase - m_run; _Pragma("unroll") for (int r = 0; r < 16; ++r) negm[r] = nm_; asm volatile("" : "+v"(negm)); \
            { const float f_ = __builtin_amdgcn_exp2f(-dl_); l_run *= f_; _Pragma("unroll") for (int r = 0; r < 16; ++r) { ot0[r] *= f_; ot1[r] *= f_; } } } } while (0)
#define SM_PV(SA, SB, vbo) do { const LAS3 unsigned char* vb_ = lds + (vbo) + va; float ls_ = 0.f; \
        _Pragma("unroll") for (int s = 0; s < 4; ++s) { u32x4 w_; \
            _Pragma("unroll") for (int j = 0; j < 4; ++j) { float e0_, e1_; \
                if (s < 2) { e0_ = __builtin_amdgcn_exp2f(SA[8 * (s & 1) + 2 * j]); e1_ = __builtin_amdgcn_exp2f(SA[8 * (s & 1) + 2 * j + 1]); } \
                else { e0_ = __builtin_amdgcn_exp2f(SB[8 * (s & 1) + 2 * j]); e1_ = __builtin_amdgcn_exp2f(SB[8 * (s & 1) + 2 * j + 1]); } \
                ls_ += e0_ + e1_; w_[j] = pk2(e0_, e1_); } \
            const bf16x8 p_ = __builtin_bit_cast(bf16x8, w_); \
            const s16x4 a0 = vtr(vb_ + s * 1024), a1 = vtr(vb_ + s * 1024 + 256), c0 = vtr(vb_ + 4096 + s * 1024), c1 = vtr(vb_ + 4096 + s * 1024 + 256); \
            const bf16x8 v0 = {a0[0], a0[1], a0[2], a0[3], a1[0], a1[1], a1[2], a1[3]}, v1 = {c0[0], c0[1], c0[2], c0[3], c1[0], c1[1], c1[2], c1[3]}; \
            ot0 = __builtin_amdgcn_mfma_f32_32x32x16_bf16(v0, p_, ot0, 0, 0, 0); \
            ot1 = __builtin_amdgcn_mfma_f32_32x32x16_bf16(v1, p_, ot1, 0, 0, 0); } \
        l_run += ls_; } while (0)
#define SM_STEP(CA, CB, NA, NB, it, LS, SS) do { \
        const bool more_ = ((it) + 2 < nt); \
        if ((it) + 3 < nt) ATT_LOAD((it) + 3, LS); \
        SM_REF(CA, CB, false, NA, NB); SM_QK(NA, NB, b_next); SM_PV(CA, CB, b_cur); SM_BIAS(NA, NB, (it) + 1, b_next); SM_BIAS_C(NA, NB, (it) + 1); \
        if (more_) ATT_STORE(b_store, SS); \
        asm volatile("s_waitcnt lgkmcnt(0)\n\ts_barrier" ::: "memory");     \
        { const int tb_ = b_cur; b_cur = b_next; b_next = b_store; b_store = tb_; } } while (0)
    ATT_LOAD(0, 0); ATT_LOAD(1, 1); ATT_STORE(0, 0); ATT_STORE(BUFB, 1); ATT_LOAD(2, 1);
    __syncthreads();
    int b_cur = 0, b_next = BUFB, b_store = 2 * BUFB;
    SM_QK(sA0, sA1, 0); SM_BIAS(sA0, sA1, 0, 0);
    { float mx_ = fmaxf(sA0[0], sA1[0]);
#pragma unroll
      for (int r = 1; r < 16; ++r) mx_ = fmaxf(mx_, fmaxf(sA0[r], sA1[r]));
      mx_ = lane32_max(mx_); m_run = mx_;
#pragma unroll
      for (int r = 0; r < 16; ++r) { sA0[r] -= mx_; sA1[r] -= mx_; negm[r] = cbase - mx_; }
      asm volatile("" : "+v"(negm)); }
    int it = 0;
    for (; it + 2 < nt; it += 2) {
        SM_STEP(sA0, sA1, sB0, sB1, it, 0, 1);
        SM_STEP(sB0, sB1, sA0, sA1, it + 1, 1, 0);
    }
    SM_STEP(sA0, sA1, sB0, sB1, it, 0, 1);
    SM_REF(sB0, sB1, false, sA0, sA1); SM_PV(sB0, sB1, b_cur);
    __syncthreads();
#undef SM_STEP
#undef SM_PV
#undef SM_REF
#undef SM_BIAS
#undef SM_BIAS_C
#undef SM_QK
#undef ATT_LOAD
#undef ATT_STORE
    const float lt = lane32_sum(l_run); const float inv = 1.0f / lt;
    bf16_t* op = P.O + (rowbase + qrow) * DM + P.oc + h * 64 + 4 * hi;
#pragma unroll
    for (int a = 0; a < 4; ++a) {
        u32x2 w0, w1; w0.x = pk2(ot0[4 * a] * inv, ot0[4 * a + 1] * inv); w0.y = pk2(ot0[4 * a + 2] * inv, ot0[4 * a + 3] * inv);
        w1.x = pk2(ot1[4 * a] * inv, ot1[4 * a + 1] * inv); w1.y = pk2(ot1[4 * a + 2] * inv, ot1[4 * a + 3] * inv);
        *(u32x2*)(op + 8 * a) = w0; *(u32x2*)(op + 32 + 8 * a) = w1;
    }
}
}
#define LAS __attribute__((address_space(3)))
typedef unsigned short bf16;
typedef unsigned v4u __attribute__((ext_vector_type(4)));
typedef float f32x4 __attribute__((ext_vector_type(4)));
typedef float f32x2 __attribute__((ext_vector_type(2)));
constexpr int NWAVES = 8, NTHR = 512;
constexpr size_t MiB = 1u << 20;
constexpr size_t WS_SS = 0;
constexpr size_t WS_QCTR = 7 * 131072;
constexpr size_t WS_BAR = WS_QCTR + 64 * 256;
constexpr size_t WS_KMAX = WS_BAR + 3456 * 4;
constexpr size_t WS_ROPE = 1 * MiB;
constexpr size_t WS_LF = 2 * MiB;
constexpr size_t WS_CUMF = 3 * MiB;
constexpr size_t WS_W_AB = 4 * MiB, WS_W_OAB = 10 * MiB, WS_W_GU0 = 12 * MiB, WS_W_DN0 = 23 * MiB, WS_W_CD = 29 * MiB, WS_W_UQ = 34 * MiB, WS_W_UKV = 35 * MiB,
                 WS_W_OCD = 36 * MiB, WS_W_GU1 = 38 * MiB, WS_W_DN1 = 49 * MiB;
constexpr size_t WS_XB = 56 * MiB;
constexpr size_t WS_BIG = 120 * MiB;
constexpr size_t WS_END = 472 * MiB;
constexpr int RING_BYTES = 131072, LDS_BYTES = 147456;

struct Args {
    const float *x, *ab_norm, *ab_w_in, *ab_rel_bias, *ab_w_o, *cd_norm, *cd_w_in, *cd_q_norm, *cd_w_uq, *cd_kv_norm, *cd_w_ukv, *cd_b_f, *cd_w_o,
                *ffn_norm, *ffn_w_gate, *ffn_w_up, *ffn_conv_w, *ffn_conv_b, *ffn_w_down, *final_norm;
    float* out; unsigned char* ws;
};

__device__ __forceinline__ unsigned f2bf(float f) { unsigned u = __builtin_bit_cast(unsigned, f); return (u + 0x7fffu + ((u >> 16) & 1u)) >> 16; }
__device__ __forceinline__ unsigned pk2f(float lo, float hi) { return f2bf(lo) | (f2bf(hi) << 16); }
__device__ __forceinline__ float bf_lo(unsigned w) { return __uint_as_float(w << 16); }
__device__ __forceinline__ float bf_hi(unsigned w) { return __uint_as_float(w & 0xffff0000u); }
__device__ __forceinline__ float wave_sum(float v) {
#pragma unroll
    for (int o = 1; o < 64; o <<= 1) v += __shfl_xor(v, o);
    return v;
}

struct WDesc { const float* W; int K, N, Npad; bf16* WT; int row_off; int ilv; const float* gain; int s0lo, s0hi; float s0; int s1lo, s1hi; float s1; };
__device__ __forceinline__ void transpose_item(const WDesc& d, LAS float* scr, int item, int lane) {
    const int nblk = d.Npad / 32, kb = item / nblk, nb = item % nblk, k0 = 64 * kb, n0 = 32 * nb;
    const int n = n0 + (lane & 31);
    const float cs = (n >= d.s0lo && n < d.s0hi) ? d.s0 : ((n >= d.s1lo && n < d.s1hi) ? d.s1 : 1.0f);
    float wv[32];
#pragma unroll
    for (int i = 0; i < 32; ++i) { const int kk = 2 * i + (lane >> 5); wv[i] = (n < d.N) ? d.W[(size_t)(k0 + kk) * d.N + n] : 0.f; }
    const float g0 = d.gain ? d.gain[k0 + lane] : 1.0f;
#pragma unroll
    for (int i = 0; i < 32; ++i) { const int kk = 2 * i + (lane >> 5); const float g = __shfl(g0, kk); scr[kk * 33 + (lane & 31)] = wv[i] * g * cs; }
    asm volatile("s_waitcnt lgkmcnt(0)" ::: "memory");
    const int c = lane & 7;
#pragma unroll
    for (int j = 0; j < 4; ++j) { const int nn = (lane >> 3) + 8 * j; const LAS float* s = scr + (8 * c) * 33 + nn;
        v4u o; o.x = pk2f(s[0 * 33], s[1 * 33]); o.y = pk2f(s[2 * 33], s[3 * 33]); o.z = pk2f(s[4 * 33], s[5 * 33]); o.w = pk2f(s[6 * 33], s[7 * 33]);
        const int rowb = d.ilv ? (256 * (n0 >> 7) + (n0 & 127) + d.row_off) : (d.row_off + n0);
        *(v4u*)(d.WT + (size_t)(rowb + nn) * d.K + k0 + 8 * c) = o; }
    asm volatile("s_waitcnt lgkmcnt(0)" ::: "memory");
}
__device__ __forceinline__ WDesc wdesc(const Args& a, int mi) {
    unsigned char* ws = a.ws; WDesc d; d.gain = nullptr; d.row_off = 0; d.ilv = 0; d.s0lo = d.s0hi = d.s1lo = d.s1hi = 0; d.s0 = d.s1 = 1.f;
    switch (mi) {
    case 0: d.W = a.ab_w_in; d.K = DM; d.N = AB_COLS; d.Npad = AB_COLS; d.WT = (bf16*)(ws + WS_W_AB); d.gain = a.ab_norm; d.s0lo = 0; d.s0hi = 512; d.s0 = 0.125f * LOG2E; d.s1lo = 1536; d.s1hi = 2048; d.s1 = 0.125f; break;
    case 1: d.W = a.ab_w_o; d.K = DM; d.N = DM; d.Npad = DM; d.WT = (bf16*)(ws + WS_W_OAB); break;
    case 2: d.W = a.ffn_w_gate; d.K = DM; d.N = FF; d.Npad = FF; d.WT = (bf16*)(ws + WS_W_GU0); d.gain = a.ffn_norm; d.ilv = 1; break;
    case 3: d.W = a.ffn_w_up; d.K = DM; d.N = FF; d.Npad = FF; d.WT = (bf16*)(ws + WS_W_GU0); d.row_off = 128; d.ilv = 1; d.gain = a.ffn_norm; break;
    case 4: d.W = a.ffn_w_down; d.K = FF; d.N = DM; d.Npad = DM; d.WT = (bf16*)(ws + WS_W_DN0); break;
    case 5: d.W = a.cd_w_in; d.K = DM; d.N = CD_COLS; d.Npad = CD_PAD; d.WT = (bf16*)(ws + WS_W_CD); d.gain = a.cd_norm; d.s0lo = 672; d.s0hi = 1184; d.s0 = 0.125f * LOG2E; break;
    case 6: d.W = a.cd_w_uq; d.K = Q_RANK; d.N = QC_COLS; d.Npad = QC_COLS; d.WT = (bf16*)(ws + WS_W_UQ); d.gain = a.cd_q_norm; d.s0lo = 0; d.s0hi = QC_COLS; d.s0 = 0.10206207261596575f * LOG2E; break;
    case 7: d.W = a.cd_w_ukv; d.K = KV_RANK; d.N = KVC_COLS; d.Npad = KVC_COLS; d.WT = (bf16*)(ws + WS_W_UKV); d.gain = a.cd_kv_norm; break;
    case 8: d.W = a.cd_w_o; d.K = DM; d.N = DM; d.Npad = DM; d.WT = (bf16*)(ws + WS_W_OCD); break;
    case 9: d.W = a.ffn_w_gate + (size_t)DM * FF; d.K = DM; d.N = FF; d.Npad = FF; d.WT = (bf16*)(ws + WS_W_GU1); d.gain = a.ffn_norm + DM; d.ilv = 1; break;
    case 10: d.W = a.ffn_w_up + (size_t)DM * FF; d.K = DM; d.N = FF; d.Npad = FF; d.WT = (bf16*)(ws + WS_W_GU1); d.row_off = 128; d.ilv = 1; d.gain = a.ffn_norm + DM; break;
    default: d.W = a.ffn_w_down + (size_t)FF * DM; d.K = FF; d.N = DM; d.Npad = DM; d.WT = (bf16*)(ws + WS_W_DN1); break;
    }
    return d;
}
__device__ __forceinline__ int witems(int mi) {
    switch (mi) { case 0: return (DM / 64) * (AB_COLS / 32); case 1: case 8: return (DM / 64) * (DM / 32); case 2: case 3: case 9: case 10: return (DM / 64) * (FF / 32);
                  case 4: case 11: return (FF / 64) * (DM / 32); case 5: return (DM / 64) * (CD_PAD / 32); case 6: return (Q_RANK / 64) * (QC_COLS / 32); default: return (KV_RANK / 64) * (KVC_COLS / 32); }
}

__device__ __forceinline__ void p0_prologue(const Args& a, LAS unsigned char* lds, int gw, int NGW, int lane, int wave) {
    unsigned char* ws = a.ws;
    { float* z = (float*)(ws + WS_SS); const int gt = gw * 64 + lane, GT = NGW * 64;
      for (int i = MTOK + gt; i < 7 * MTOK + 64 * 64 + 3456 + 64; i += GT) z[i] = 0.f; }
    { f32x2* rt = (f32x2*)(ws + WS_ROPE); const int gt = gw * 64 + lane, GT = NGW * 64;
      for (int i = gt; i < SEQ * 16; i += GT) { const int pos = i >> 4, j = i & 15;
          const float inv = exp2f(-(float)j * (13.287712379549449f / 16.0f));
          const float ang = (float)pos * inv;
          const double turns = (double)ang * 0.15915494309189535; const float fr = (float)(turns - floor(turns));
          rt[i] = (f32x2){__builtin_amdgcn_cosf(fr), __builtin_amdgcn_sinf(fr)}; } }
    LAS float* scr = (LAS float*)(lds + wave * 16384);
    { int base = 0;
      for (int mi = 0; mi < 12; ++mi) { const int ni = witems(mi); const WDesc d = wdesc(a, mi);
          int first = gw - (base % NGW); if (first < 0) first += NGW;
          for (int it = first; it < ni; it += NGW) transpose_item(d, scr, it, lane);
          base += ni; } }
    { float* ss0 = (float*)(ws + WS_SS); bf16* xb = (bf16*)(ws + WS_XB);
      for (int m0 = gw * 4; m0 < MTOK; m0 += NGW * 4) {
          f32x4 v[4][4];
#pragma unroll
          for (int r = 0; r < 4; ++r) { const f32x4* xr = (const f32x4*)(a.x + (size_t)(m0 + r) * DM) + lane;
#pragma unroll
              for (int j = 0; j < 4; ++j) v[r][j] = __builtin_nontemporal_load(xr + 64 * j); }
#pragma unroll
          for (int r = 0; r < 4; ++r) { unsigned long long* o8 = (unsigned long long*)(xb + (size_t)(m0 + r) * DM) + lane; float s = 0.f;
#pragma unroll
              for (int j = 0; j < 4; ++j) { const f32x4 w = v[r][j]; s += (w.x * w.x + w.y * w.y) + (w.z * w.z + w.w * w.w); o8[64 * j] = (unsigned long long)pk2f(w.x, w.y) | ((unsigned long long)pk2f(w.z, w.w) << 32); }
              s = wave_sum(s); if (lane == 0) ss0[m0 + r] = s; } } }
}

__device__ __forceinline__ void act_phase(bf16* gu, const float* cw, const float* cb, int gtid, int GT) {
    constexpr int NCH = FF / 8, RB = 32;
    for (int it = gtid; it < (MTOK / RB) * NCH; it += GT) {
        const int ch = it % NCH, rb = it / NCH, r0 = rb * RB, c = ch * 8;
        float w0[8], w1[8], w2[8], bb[8];
#pragma unroll
        for (int e = 0; e < 8; ++e) { w0[e] = cw[c + e]; w1[e] = cw[FF + c + e]; w2[e] = cw[2 * FF + c + e]; bb[e] = cb[c + e]; }
        float g2[8], g1[8];
        if ((r0 & (SEQ - 1)) == 0) {
#pragma unroll
            for (int e = 0; e < 8; ++e) { g2[e] = 0.f; g1[e] = 0.f; }
        } else {
            const v4u a2 = *(const v4u*)(gu + (size_t)(r0 - 2) * FF2 + c), a1 = *(const v4u*)(gu + (size_t)(r0 - 1) * FF2 + c);
            g2[0] = bf_lo(a2.x); g2[1] = bf_hi(a2.x); g2[2] = bf_lo(a2.y); g2[3] = bf_hi(a2.y); g2[4] = bf_lo(a2.z); g2[5] = bf_hi(a2.z); g2[6] = bf_lo(a2.w); g2[7] = bf_hi(a2.w);
            g1[0] = bf_lo(a1.x); g1[1] = bf_hi(a1.x); g1[2] = bf_lo(a1.y); g1[3] = bf_hi(a1.y); g1[4] = bf_lo(a1.z); g1[5] = bf_hi(a1.z); g1[6] = bf_lo(a1.w); g1[7] = bf_hi(a1.w);
        }
#pragma unroll 4
        for (int r = 0; r < RB; ++r) {
            bf16* gp = gu + (size_t)(r0 + r) * FF2 + c;
            const v4u ag = *(const v4u*)gp, au = *(const v4u*)(gp + FF);
            float g0[8], uu[8], y[8];
            g0[0] = bf_lo(ag.x); g0[1] = bf_hi(ag.x); g0[2] = bf_lo(ag.y); g0[3] = bf_hi(ag.y); g0[4] = bf_lo(ag.z); g0[5] = bf_hi(ag.z); g0[6] = bf_lo(ag.w); g0[7] = bf_hi(ag.w);
            uu[0] = bf_lo(au.x); uu[1] = bf_hi(au.x); uu[2] = bf_lo(au.y); uu[3] = bf_hi(au.y); uu[4] = bf_lo(au.z); uu[5] = bf_hi(au.z); uu[6] = bf_lo(au.w); uu[7] = bf_hi(au.w);
#pragma unroll
            for (int e = 0; e < 8; ++e) { const float xg = w0[e] * g2[e] + w1[e] * g1[e] + w2[e] * g0[e] + bb[e]; y[e] = xg * __builtin_amdgcn_rcpf(1.0f + __expf(-xg)) * uu[e]; g2[e] = g1[e]; g1[e] = g0[e]; }
            v4u o; o.x = pk2f(y[0], y[1]); o.y = pk2f(y[2], y[3]); o.z = pk2f(y[4], y[5]); o.w = pk2f(y[6], y[7]);
            *(v4u*)(gp + FF) = o;
        }
    }
}

__device__ __forceinline__ void ffn_fixup(const float* gf, const float* uf, const float* gl, const float* cw, const float* cb, bf16* Y, int gtid, int GT) {
    constexpr int NC4 = FF / 4, NG = MTOK / 64;
    for (int it = gtid; it < NG * 2 * NC4; it += GT) {
        const int c = (it % NC4) * 4, j = (it / NC4) & 1, g = it / (2 * NC4);
        const bool seq0 = (g & (SEQ / 64 - 1)) == 0;
        const f32x4 z = {0.f, 0.f, 0.f, 0.f};
        const f32x4 g0 = *(const f32x4*)(gf + (size_t)(g * 2 + j) * FF + c), u0 = *(const f32x4*)(uf + (size_t)(g * 2 + j) * FF + c);
        const f32x4 l0 = seq0 ? z : *(const f32x4*)(gl + (size_t)((g - 1) * 2 + 0) * FF + c), l1 = seq0 ? z : *(const f32x4*)(gl + (size_t)((g - 1) * 2 + 1) * FF + c);
        const f32x4 g1 = j ? *(const f32x4*)(gf + (size_t)(g * 2) * FF + c) : l1, g2 = j ? l1 : l0;
        const f32x4 w0 = *(const f32x4*)(cw + c), w1 = *(const f32x4*)(cw + FF + c), w2 = *(const f32x4*)(cw + 2 * FF + c), bb = *(const f32x4*)(cb + c);
        const f32x4 xg = w0 * g2 + w1 * g1 + w2 * g0 + bb; float y[4];
#pragma unroll
        for (int e = 0; e < 4; ++e) y[e] = xg[e] * __builtin_amdgcn_rcpf(1.0f + __expf(-xg[e])) * u0[e];
        unsigned long long o = (unsigned long long)pk2f(y[0], y[1]) | ((unsigned long long)pk2f(y[2], y[3]) << 32);
        *(unsigned long long*)(Y + (size_t)(g * 64 + j) * FF + c) = o;
    }
}

__device__ __forceinline__ void cumf_block(const float* lf, float* cumf, int bh, LAS float* scr, int tid) {
    const int b = bh >> 3, h = bh & 7, t0 = tid * 16, lane = tid & 63, wave = tid >> 6;
    float v[16]; float s = 0.f;
#pragma unroll
    for (int i = 0; i < 16; ++i) { s += lf[((size_t)b * SEQ + t0 + i) * 8 + h]; v[i] = s; }
    float incl = s;
#pragma unroll
    for (int o = 1; o < 64; o <<= 1) { const float up = __shfl_up(incl, o); if (lane >= o) incl += up; }
    if (lane == 63) scr[wave] = incl;
    __syncthreads();
    float woff = 0.f;
    for (int w = 0; w < wave; ++w) woff += scr[w];
    const float off = woff + incl - s;
    float* o = cumf + (size_t)bh * SEQ + t0;
#pragma unroll
    for (int i = 0; i < 16; ++i) o[i] = off + v[i];
    __syncthreads();
}

__device__ __forceinline__ void kmax_block(const bf16* kd  , unsigned* kmax_bits, int blk, int tid) {
    const int bh = blk >> 3, seg = blk & 7, b = bh >> 3, h = bh & 7, lj = tid & 7, kl = tid >> 3;
    const bf16* p = kd + ((size_t)b * SEQ + seg * 1024 + kl) * CD_PAD + h * 64 + lj * 8;
    v4u w[16];
#pragma unroll
    for (int i = 0; i < 16; ++i) w[i] = *(const v4u*)(p + (size_t)i * 64 * CD_PAD);
    float mx = 0.f;
#pragma unroll
    for (int i = 0; i < 16; ++i) { float s = 0.f;
#pragma unroll
        for (int e = 0; e < 4; ++e) { const float lo = bf_lo(w[i][e]), hi = bf_hi(w[i][e]); s += lo * lo + hi * hi; }
        s += __shfl_xor(s, 1); s += __shfl_xor(s, 2); s += __shfl_xor(s, 4); mx = fmaxf(mx, s); }
#pragma unroll
    for (int o = 8; o < 64; o <<= 1) mx = fmaxf(mx, __shfl_xor(mx, o));
    if ((tid & 63) == 0) atomicMax(kmax_bits + bh, __float_as_uint(sqrtf(mx)));
}

template <int LAYER>
__device__ __forceinline__ void attn_phase(const att::Ptrs& P0, const att::Ptrs& P1, unsigned* ctr, LAS unsigned char* lds) {
    const int x0 = blockIdx.x & 7;
    volatile LAS int* qidx = (volatile LAS int*)(lds + att::QIDX_OFF);
#pragma unroll 1
    for (int q = 0; q < 8; ++q) {
        const int x = (x0 + q) & 7; unsigned* my = ctr + x * 64;
        for (;;) {
            if (threadIdx.x == 0) *qidx = (int)atomicAdd(my, 1u);
            __syncthreads();
            const int i = *qidx;
            __syncthreads();
            if (i >= 256) break;
            if (LAYER == 0) {
                if (i < 128) att::attn_unit<1>(P1, i & 3, x, 31 - (i >> 2), lds);
                else { const int j = i - 128; att::attn_unit<0>(P0, j >> 5, x, 31 - (j & 31), lds); }
            } else {
                const int j = i & 127, qb = 31 - (j >> 2), b = j & 3;
                if (i >= 128) att::attn_unit<3>(P1, b, x, qb, lds);
                else att::attn_unit_sm<2>(P0, b, x, qb, lds);
            }
        }
    }
}

typedef __attribute__((address_space(1))) unsigned gu32;
#define XB_TMO      128
#define XB_XCNT(j)  (256  + 64 * (j))
#define XB_XSUB(j)  (1280 + 64 * (j))
#define XB_XGEN(j)  (2304 + 64 * (j))
#define XB_TOP      3328
#define XB_TOPGEN   3392
#define XCD_BAR_WORDS 3456
#define XB_SPIN_CAP (1u << 18)

__device__ __forceinline__ unsigned xb_ld(unsigned* p)              { return __hip_atomic_load(p, __ATOMIC_RELAXED, __HIP_MEMORY_SCOPE_AGENT); }
__device__ __forceinline__ unsigned xb_add(unsigned* p, unsigned v) { return __hip_atomic_fetch_add(p, v, __ATOMIC_RELAXED, __HIP_MEMORY_SCOPE_AGENT); }
__device__ __forceinline__ unsigned xb_xcc_id() { return (unsigned)__builtin_amdgcn_s_getreg((3 << 11) | 20) & 0xFu; }
#define XB_SPIN(cond, bar) do { unsigned _sp = 0; while (cond) { __builtin_amdgcn_s_sleep(1); \
    if ((++_sp & 255u) == 0u) { if (xb_ld(&(bar)[XB_TMO])) break; if (_sp > XB_SPIN_CAP) { atomicAdd(&(bar)[XB_TMO], 1u); break; } } } } while (0)

struct XcdBarrier {
    unsigned* bar; unsigned x;
    volatile LAS unsigned* st;
};

__device__ __forceinline__ XcdBarrier xcd_barrier_post(unsigned* bar, volatile LAS unsigned* st) {
    XcdBarrier b; b.bar = bar; b.x = xb_xcc_id(); b.st = st;
    if (threadIdx.x == 0) (void)xb_add(&bar[XB_XCNT(b.x)], 1u);
    return b;
}
__device__ __forceinline__ void xcd_barrier_complete(unsigned* bar, unsigned x, unsigned& nloc, unsigned& nx) {
    const unsigned G = gridDim.x * gridDim.y * gridDim.z;
    unsigned sum, cnt, mine, sp = 0u;
    for (;;) {
        sum = 0u; cnt = 0u; mine = 0u;
#pragma unroll
        for (unsigned j = 0; j < 16; ++j) { const unsigned c = xb_ld(&bar[XB_XCNT(j)]); sum += c; cnt += (c > 0u) ? 1u : 0u; mine = (j == x) ? c : mine; }
        if (sum == G) break;
        __builtin_amdgcn_s_sleep(1);
        if ((++sp & 255u) == 0u) { if (xb_ld(&bar[XB_TMO])) break; if (sp > XB_SPIN_CAP) { atomicAdd(&bar[XB_TMO], 1u); break; } }
    }
    nloc = mine > 0u ? mine : 1u; nx = cnt > 0u ? cnt : 1u;
}

__device__ __forceinline__ void xcd_barrier(const XcdBarrier& b) {
    asm volatile("s_waitcnt vmcnt(0)" ::: "memory");
    __syncthreads();
    if (threadIdx.x == 0) {
        unsigned* bar = b.bar;
        __builtin_amdgcn_s_waitcnt(0);
        unsigned nloc = b.st[0], nx = b.st[1];
        if (nloc == 0u) { xcd_barrier_complete(bar, b.x, nloc, nx); b.st[0] = nloc; b.st[1] = nx; }
        const unsigned old = xb_add(&bar[XB_XSUB(b.x)], 1u);
        const unsigned gen = old / nloc;
        if (old + 1u == (gen + 1u) * nloc) {
            __builtin_amdgcn_fence(__ATOMIC_RELEASE, "agent");
            asm volatile("s_waitcnt vmcnt(0)" ::: "memory");
            const unsigned og = xb_add(&bar[XB_TOP], 1u);
            const unsigned tg = og / nx;
            if (og + 1u == (tg + 1u) * nx) xb_add(&bar[XB_TOPGEN], 1u);
            else XB_SPIN(xb_ld(&bar[XB_TOPGEN]) == tg, bar);
            __builtin_amdgcn_fence(__ATOMIC_ACQUIRE, "agent");
            xb_add(&bar[XB_XGEN(b.x)], 1u);
            asm volatile("s_waitcnt vmcnt(0)" ::: "memory");
        } else {
            XB_SPIN(xb_ld(&bar[XB_XGEN(b.x)]) == gen, bar);
            __builtin_amdgcn_fence(__ATOMIC_ACQUIRE, "agent");
            asm volatile("s_waitcnt vmcnt(0)" ::: "memory");
        }
    }
    __syncthreads();
}

__device__ __forceinline__ int fresh_tid() { int t = threadIdx.x; asm volatile("" : "+v"(t)); return t; }
__global__ void __launch_bounds__(NTHR, 2) mk_fwd(Args a) {
    extern __shared__ __attribute__((aligned(16))) unsigned char lds_raw[];
    LAS unsigned char* lds = (LAS unsigned char*)lds_raw;
    cg::grid_group grid = cg::this_grid();
    const int G = gridDim.x, bx = blockIdx.x;
    const int NGW = G * NWAVES, GT = G * NTHR;
    unsigned char* ws = a.ws;
    float* SS = (float*)(ws + WS_SS);
    float *ss0 = SS, *ss1 = SS + MTOK, *ss2 = SS + 2 * MTOK, *ss3 = SS + 3 * MTOK, *ss4 = SS + 4 * MTOK, *ssq = SS + 5 * MTOK, *sskv = SS + 6 * MTOK;
    unsigned* qctr = (unsigned*)(ws + WS_QCTR);
    const f32x2* rope = (const f32x2*)(ws + WS_ROPE);
    float* lf = (float*)(ws + WS_LF); float* cumf = (float*)(ws + WS_CUMF); const float* kmaxp = (const float*)(ws + WS_KMAX);
    bf16* XB = (bf16*)(ws + WS_XB);
    bf16* BIG = (bf16*)(ws + WS_BIG);
    bf16* QKV = BIG; bf16* O0 = (bf16*)(ws + WS_BIG + 192 * MiB);
    bf16* PROJ = BIG; bf16* QC = (bf16*)(ws + WS_BIG + 144 * MiB); bf16* KVC = (bf16*)(ws + WS_BIG + 192 * MiB); bf16* O1 = (bf16*)(ws + WS_BIG + 256 * MiB);
    bf16* YB = BIG;
    float* stash_gf = (float*)(ws + WS_BIG + 192 * MiB); float* stash_uf = stash_gf + (size_t)(MTOK / 64) * 2 * FF; float* stash_gl = stash_uf + (size_t)(MTOK / 64) * 2 * FF;
    using pg8::Gemm; using pg8::StaticOrder;

    { volatile LAS unsigned* misc0 = (volatile LAS unsigned*)(lds + RING_BYTES + 320); if (threadIdx.x < 32) misc0[threadIdx.x] = 0u; }
    __syncthreads();
    { const int tid = fresh_tid(), lane = tid & 63, wave = __builtin_amdgcn_readfirstlane(tid >> 6); p0_prologue(a, lds, bx * NWAVES + wave, NGW, lane, wave); }
    grid.sync();
    (void)xcd_barrier_post((unsigned*)(ws + WS_BAR), (volatile LAS unsigned*)(lds + RING_BYTES + 320) + 8);
#define XBAR() do { XcdBarrier xb_; xb_.bar = (unsigned*)(a.ws + WS_BAR); xb_.x = xb_xcc_id(); xb_.st = (volatile LAS unsigned*)(lds + RING_BYTES + 320) + 8; xcd_barrier(xb_); } while (0)


#ifndef SKIP_P1
    { Gemm g{XB, (const bf16*)(ws + WS_W_AB), MTOK, AB_COLS, DM, DM}; StaticOrder S; S.init(MTOK, AB_COLS, G, bx);
      pg8::EpiScaleBf16 E{QKV, AB_COLS, ss0, 1.0f / DM};
      pg8::gemm_phase<pg8::EpiScaleBf16, StaticOrder, true, true>(lds, g, S, E); }
#endif
    XBAR();

#ifndef SKIP_ATT0
    { att::Ptrs PA{QKV, AB_COLS, 64, QKV + 512, AB_COLS, 64, nullptr, 0, QKV + 1024, AB_COLS, 64, O0, 0, a.ab_rel_bias, nullptr};
      att::Ptrs PB{QKV + 1536, AB_COLS, 64, QKV + 2048, AB_COLS, 64, nullptr, 0, QKV + 2560, AB_COLS, 64, O0, 512, nullptr, nullptr};
      attn_phase<0>(PA, PB, qctr, lds); }
#endif
    XBAR();

#ifndef SKIP_P3
    { Gemm g{O0, (const bf16*)(ws + WS_W_OAB), MTOK, DM, DM, DM}; StaticOrder S; S.init(MTOK, DM, G, bx);
      pg8::EpiResid E{a.x, nullptr, nullptr, XB, ss1};
      pg8::gemm_phase<pg8::EpiResid, StaticOrder, true, true>(lds, g, S, E); }
#endif
    XBAR();
#pragma unroll 1
    for (int layer = 0; layer < 2; ++layer) {

#ifndef SKIP_GU
        { Gemm g{XB, (const bf16*)(ws + (layer ? WS_W_GU1 : WS_W_GU0)), MTOK, FF2, DM, DM}; StaticOrder S; S.init(MTOK, FF2, G, bx);
          pg8::EpiGU E{YB, layer ? ss3 : ss1, a.ffn_conv_w + (size_t)layer * 3 * FF, a.ffn_conv_b + (size_t)layer * FF, stash_gf, stash_uf, stash_gl};
          pg8::gemm_phase<pg8::EpiGU, StaticOrder, true, true>(lds, g, S, E); }
#endif
        XBAR();

#ifndef SKIP_ACT
        ffn_fixup(stash_gf, stash_uf, stash_gl, a.ffn_conv_w + (size_t)layer * 3 * FF, a.ffn_conv_b + (size_t)layer * FF, YB, bx * NTHR + fresh_tid(), GT);
#endif
        XBAR();

#ifndef SKIP_DN
        { Gemm g{YB, (const bf16*)(ws + (layer ? WS_W_DN1 : WS_W_DN0)), MTOK, DM, FF, FF}; StaticOrder S; S.init(MTOK, DM, G, bx);
          pg8::EpiResid E{nullptr, XB, nullptr, XB, layer ? ss4 : ss2};
          pg8::gemm_phase<pg8::EpiResid, StaticOrder, true, true>(lds, g, S, E); }
#endif
        XBAR();
        if (layer == 0) {

#ifndef SKIP_CD
            { Gemm g{XB, (const bf16*)(ws + WS_W_CD), MTOK, CD_PAD, DM, DM}; StaticOrder S; S.init(MTOK, CD_PAD, G, bx);
              pg8::EpiCD E{PROJ, ss2, ssq, sskv, lf, a.cd_b_f, (const pg8::f32x2*)rope};
              pg8::gemm_phase<pg8::EpiCD, StaticOrder, true, true>(lds, g, S, E); }
#endif
            XBAR();

#ifndef SKIP_P8
#ifndef SKIP_CUMF
            kmax_block(PROJ + 1184, (unsigned*)(ws + WS_KMAX), bx, fresh_tid());
            if (bx < 32) cumf_block(lf, cumf, bx, (LAS float*)lds, fresh_tid());
#endif
#ifndef SKIP_QUP
            { Gemm g{PROJ, (const bf16*)(ws + WS_W_UQ), MTOK, QC_COLS, Q_RANK, CD_PAD}; StaticOrder S; S.init(MTOK, QC_COLS, G, bx);
              pg8::EpiQ E{QC, ssq, (const pg8::f32x2*)rope};
              pg8::gemm_phase<pg8::EpiQ, StaticOrder, true, true>(lds, g, S, E); }
#endif
#ifndef SKIP_KVUP
            { Gemm g{PROJ + Q_RANK, (const bf16*)(ws + WS_W_UKV), MTOK, KVC_COLS, KV_RANK, CD_PAD}; StaticOrder S; S.init(MTOK, KVC_COLS, G, bx);
              pg8::EpiScaleBf16 E{KVC, KVC_COLS, sskv, 1.0f / KV_RANK};
              pg8::gemm_phase<pg8::EpiScaleBf16, StaticOrder, true, true>(lds, g, S, E); }
#endif
#endif
            XBAR();

#ifndef SKIP_ATT1
            { att::Ptrs PC{QC, QC_COLS, 96, KVC, KVC_COLS, 128, PROJ + 640, CD_PAD, KVC + 64, KVC_COLS, 128, O1, 0, nullptr, nullptr};
              att::Ptrs PD{PROJ + 672, CD_PAD, 64, PROJ + 1184, CD_PAD, 64, nullptr, 0, PROJ + 1696, CD_PAD, 64, O1, 512, cumf, kmaxp};
              attn_phase<1>(PC, PD, qctr + 8 * 64, lds); }
#endif
            XBAR();

#ifndef SKIP_P10
            { Gemm g{O1, (const bf16*)(ws + WS_W_OCD), MTOK, DM, DM, DM}; StaticOrder S; S.init(MTOK, DM, G, bx);
              pg8::EpiResid E{nullptr, XB, nullptr, XB, ss3};
              pg8::gemm_phase<pg8::EpiResid, StaticOrder, true, true>(lds, g, S, E); }
#endif
            XBAR();
        }
    }
    const int tidf = fresh_tid(), lane = tidf & 63, gw = bx * NWAVES + __builtin_amdgcn_readfirstlane(tidf >> 6);
    { const f32x4* gr = (const f32x4*)a.final_norm + lane; f32x4 gg[4];
#pragma unroll
      for (int j = 0; j < 4; ++j) gg[j] = gr[64 * j];
      for (int m0 = gw * 4; m0 < MTOK; m0 += NGW * 4) { unsigned long long v[4][4]; float rs[4];
#pragma unroll
          for (int r = 0; r < 4; ++r) { const unsigned long long* xr = (const unsigned long long*)(XB + (size_t)(m0 + r) * DM) + lane; rs[r] = rsqrtf(ss4[m0 + r] * (1.0f / DM) + RMS_EPS);
#pragma unroll
              for (int j = 0; j < 4; ++j) v[r][j] = xr[64 * j]; }
#pragma unroll
          for (int r = 0; r < 4; ++r) { f32x4* xw = (f32x4*)(a.out + (size_t)(m0 + r) * DM) + lane;
#pragma unroll
              for (int j = 0; j < 4; ++j) { const unsigned lo = (unsigned)v[r][j], hi = (unsigned)(v[r][j] >> 32); const f32x4 x4 = {bf_lo(lo), bf_hi(lo), bf_lo(hi), bf_hi(hi)};
                  __builtin_nontemporal_store(x4 * rs[r] * gg[j], xw + 64 * j); } } } }
}

extern "C" void kernel_launch(void* const* d_in, const int* in_sizes, int n_in, void* d_out, int out_size, void* d_ws, size_t ws_size, hipStream_t stream) {
    static int grid = 0;
    if (grid == 0) {
        if (n_in != 20 || in_sizes[0] != MTOK * DM || out_size != MTOK * DM || ws_size < WS_END) { fprintf(stderr, "kernel_launch: unexpected shapes / workspace (n_in %d, in0 %d, out %d, ws %zu, need %zu)\n", n_in, n_in > 0 ? in_sizes[0] : -1, out_size, ws_size, (size_t)WS_END); grid = -1; return; }
        int dev = 0, cus = 0, per_cu = 0;
        if (hipGetDevice(&dev) != hipSuccess || hipDeviceGetAttribute(&cus, hipDeviceAttributeMultiprocessorCount, dev) != hipSuccess) { grid = -1; return; }
        if (hipFuncSetAttribute((const void*)mk_fwd, hipFuncAttributeMaxDynamicSharedMemorySize, LDS_BYTES) != hipSuccess) { fprintf(stderr, "kernel_launch: hipFuncSetAttribute failed\n"); grid = -1; return; }
        if (hipOccupancyMaxActiveBlocksPerMultiprocessor(&per_cu, (const void*)mk_fwd, NTHR, LDS_BYTES) != hipSuccess || per_cu < 1) { fprintf(stderr, "kernel_launch: occupancy query says %d blocks per CU\n", per_cu); }
        (void)hipGetLastError();
        grid = cus;
    }
    if (grid < 0) return;
    Args a{};
    const float** p = (const float**)&a;
    for (int i = 0; i < 20; ++i) p[i] = (const float*)d_in[i];
    a.out = (float*)d_out; a.ws = (unsigned char*)d_ws;
    void* args[] = {&a};
    hipError_t e = hipLaunchCooperativeKernel((const void*)mk_fwd, dim3(grid), dim3(NTHR), args, LDS_BYTES, stream);
    if (e != hipSuccess) fprintf(stderr, "cooperative launch failed: %s (grid %d)\n", hipGetErrorString(e), grid);
}
```

```cpp
#include <hip/hip_runtime.h>
#include <hip/hip_cooperative_groups.h>
#include <cstdio>
#include <cstdint>
namespace cg = cooperative_groups;

constexpr int BATCH = 4, SEQ = 8192, DM = 1024, MTOK = BATCH * SEQ;
constexpr int AB_COLS = 3072, CD_COLS = 2216, CD_PAD = 2304, FF = 2816, FF2 = 2 * FF;
constexpr int Q_RANK = 384, KV_RANK = 256, QC_COLS = 768, KVC_COLS = 1024;
constexpr float RMS_EPS = 1e-6f, LOG2E = 1.4426950408889634f;
namespace pg8 {
#define PG8_LAS __attribute__((address_space(3)))
typedef unsigned short bf16_t;
typedef short bf16x8 __attribute__((ext_vector_type(8)));
typedef float f32x4 __attribute__((ext_vector_type(4)));
typedef unsigned u32x4 __attribute__((ext_vector_type(4)));
constexpr int BM = 256, BK = 64, HALF = 128, HTB = HALF * BK * 2  , STAGE_BYTES = 8 * HTB, NXCD = 8, WGM = 8;

__host__ __device__ __forceinline__ int lds_byte(int r, int c) { const int st = (r >> 4) * 2 + (c >> 5), rr = r & 15, cc = c & 31, ob = rr * 64 + cc * 2; return st * 1024 + (ob ^ (((ob >> 9) & 1) << 5)); }
__host__ __device__ __forceinline__ void stage_rc(int b, int& R, int& C) { const int st = b / 1024, sb = b % 1024, swz = sb ^ (((sb >> 9) & 1) << 5); R = (st >> 1) * 16 + swz / 64; C = (st & 1) * 32 + (swz % 64) / 2; }
__host__ __device__ __forceinline__ int perm32(int rho) { const int n = rho >> 4, i = rho & 15; return 8 * (i >> 2) + 4 * n + (i & 3); }

struct Unit { int pm, pn; };
struct Gemm { const bf16_t* A; const bf16_t* Bt; int M, N, K, lda; };

struct StaticOrder {
    int nM, nN, nwg, G, c;
    __host__ __device__ void init(int M, int N, int G_, int c_) { nM = M / BM; nN = N / BM; nwg = nM * nN; G = G_; c = c_; }
    __host__ __device__ bool next(int i, Unit& u) const {
        const long L = (long)i * G + c; if (L >= nwg) return false;
        int wgid = (int)L; { const int q = nwg / NXCD, r = nwg % NXCD, xcd = wgid % NXCD, off = wgid / NXCD; wgid = (xcd < r ? xcd * (q + 1) : r * (q + 1) + (xcd - r) * q) + off; }
        const int nig = WGM * nN, gid = wgid / nig, fm = gid * WGM, gsz = (nM - fm) < WGM ? (nM - fm) : WGM;
        u.pm = fm + ((wgid % nig) % gsz); u.pn = (wgid % nig) / gsz; return true;
    }
    __device__ __forceinline__ void a_ready(const Unit&) const {}
    __device__ __forceinline__ void done(const Unit&) const {}
};

__device__ __forceinline__ unsigned cvt_pk_bf16(float lo, float hi) { unsigned r; asm volatile("v_cvt_pk_bf16_f32 %0, %1, %2" : "=v"(r) : "v"(lo), "v"(hi)); return r; }
typedef unsigned u32x2 __attribute__((ext_vector_type(2)));
typedef float f32x2 __attribute__((ext_vector_type(2)));

struct EpiScaleBf16 {
    static constexpr bool PERM = true, AFTER_DRAIN = false;
    bf16_t* O; int ldc; const float* ss; float inv_n;
    __device__ __forceinline__ void operator()(const f32x4 (&acc)[2][2][4][2], const Unit& u, int wr, int wc, int fr, int fq) const {
        const int row0 = u.pm * BM + wr * 64 + fr; const int col0 = u.pn * BM + wc * 32 + 8 * fq;
#pragma unroll
        for (int ai = 0; ai < 2; ++ai)
#pragma unroll
            for (int m = 0; m < 4; ++m) { const int row = row0 + ai * HALF + m * 16; const float rs = rsqrtf(ss[row] * inv_n + RMS_EPS); bf16_t* rowp = O + (size_t)row * ldc + col0;
#pragma unroll
                for (int bj = 0; bj < 2; ++bj) { const f32x4 v0 = acc[ai][bj][m][0] * rs, v1 = acc[ai][bj][m][1] * rs;
                    u32x4 w; w.x = cvt_pk_bf16(v0[0], v0[1]); w.y = cvt_pk_bf16(v0[2], v0[3]); w.z = cvt_pk_bf16(v1[0], v1[1]); w.w = cvt_pk_bf16(v1[2], v1[3]);
                    *(u32x4*)(rowp + bj * HALF) = w; } }
    }
};

struct EpiResid {
    static constexpr bool PERM = false, AFTER_DRAIN = false;
    const float* base32; const bf16_t* base16; float* out; bf16_t* xb; float* ss;
    __device__ __forceinline__ void operator()(const f32x4 (&acc)[2][2][4][2], const Unit& u, int wr, int wc, int fr, int fq) const {
        const int col0 = u.pn * BM + wc * 32 + 4 * fq;
#pragma unroll
        for (int ai = 0; ai < 2; ++ai)
#pragma unroll
            for (int m = 0; m < 4; ++m) { const int row = u.pm * BM + ai * HALF + wr * 64 + m * 16 + fr; const size_t off = (size_t)row * DM + col0; float s = 0.f;
#pragma unroll
                for (int bj = 0; bj < 2; ++bj)
#pragma unroll
                    for (int n = 0; n < 2; ++n) { const size_t o2 = off + bj * HALF + n * 16; f32x4 bv;
                        if (base32) bv = *(const f32x4*)(base32 + o2);
                        else { const u32x2 bw = *(const u32x2*)(base16 + o2); bv[0] = __uint_as_float(bw.x << 16); bv[1] = __uint_as_float(bw.x & 0xffff0000u); bv[2] = __uint_as_float(bw.y << 16); bv[3] = __uint_as_float(bw.y & 0xffff0000u); }
                        const f32x4 v = bv + acc[ai][bj][m][n];
                        if (out) *(f32x4*)(out + o2) = v;
                        s += (v[0] * v[0] + v[1] * v[1]) + (v[2] * v[2] + v[3] * v[3]);
                        { u32x2 w; w.x = cvt_pk_bf16(v[0], v[1]); w.y = cvt_pk_bf16(v[2], v[3]); *(u32x2*)(xb + o2) = w; } }
                s += __shfl_xor(s, 16); s += __shfl_xor(s, 32);
                if (fq == 0) atomicAdd(ss + row, s);
                asm volatile("" ::: "memory"); }
    }
};

struct EpiCD {
    static constexpr bool PERM = false, AFTER_DRAIN = false;
    bf16_t* proj; const float* ss_in; float* ssq; float* sskv; float* lf; const float* b_f; const f32x2* rope;
    __device__ __forceinline__ void operator()(const f32x4 (&acc)[2][2][4][2], const Unit& u, int wr, int wc, int fr, int fq) const {
#pragma unroll
        for (int ai = 0; ai < 2; ++ai)
#pragma unroll
            for (int m = 0; m < 4; ++m) { const int row = u.pm * BM + ai * HALF + wr * 64 + m * 16 + fr; const float rs = rsqrtf(ss_in[row] * (1.0f / DM) + RMS_EPS); const int pos = row & (SEQ - 1);
#pragma unroll
                for (int bj = 0; bj < 2; ++bj) { const int cbase = u.pn * BM + bj * HALF + wc * 32;
                    f32x4 v0 = acc[ai][bj][m][0] * rs, v1 = acc[ai][bj][m][1] * rs;
                    if (cbase < Q_RANK + KV_RANK) {
                        float s = ((v0[0] * v0[0] + v0[1] * v0[1]) + (v0[2] * v0[2] + v0[3] * v0[3])) + ((v1[0] * v1[0] + v1[1] * v1[1]) + (v1[2] * v1[2] + v1[3] * v1[3]));
                        s += __shfl_xor(s, 16); s += __shfl_xor(s, 32);
                        if (fq == 0) atomicAdd((cbase < Q_RANK ? ssq : sskv) + row, s);
                    } else if (cbase == Q_RANK + KV_RANK) {
#pragma unroll
                        for (int e = 0; e < 4; ++e) { const f32x2 cs = rope[pos * 16 + 4 * fq + e]; const float x1 = v0[e], x2 = v1[e]; v0[e] = x1 * cs.x - x2 * cs.y; v1[e] = x2 * cs.x + x1 * cs.y; }
                    } else if (cbase == 2208) {
                        if (fq < 2) {
#pragma unroll
                            for (int e = 0; e < 4; ++e) { const int h = 4 * fq + e; const float z = v0[e] + b_f[h]; const float ls = -(fmaxf(-z, 0.f) + logf(1.0f + expf(-fabsf(z)))); lf[(size_t)row * 8 + h] = ls * LOG2E; }
                        }
                    }
                    if (cbase < 2208) { bf16_t* p = proj + (size_t)row * CD_PAD + cbase + 4 * fq;
                        u32x2 w0, w1; w0.x = cvt_pk_bf16(v0[0], v0[1]); w0.y = cvt_pk_bf16(v0[2], v0[3]); w1.x = cvt_pk_bf16(v1[0], v1[1]); w1.y = cvt_pk_bf16(v1[2], v1[3]);
                        *(u32x2*)p = w0; *(u32x2*)(p + 16) = w1; } }
                asm volatile("" ::: "memory"); }
    }
};

struct EpiQ {
    static constexpr bool PERM = false, AFTER_DRAIN = false;
    bf16_t* qc; const float* ssq; const f32x2* rope;
    __device__ __forceinline__ void operator()(const f32x4 (&acc)[2][2][4][2], const Unit& u, int wr, int wc, int fr, int fq) const {
#pragma unroll
        for (int ai = 0; ai < 2; ++ai)
#pragma unroll
            for (int m = 0; m < 4; ++m) { const int row = u.pm * BM + ai * HALF + wr * 64 + m * 16 + fr; const float rs = rsqrtf(ssq[row] * (1.0f / Q_RANK) + RMS_EPS); const int pos = row & (SEQ - 1);
#pragma unroll
                for (int bj = 0; bj < 2; ++bj) { const int cbase = u.pn * BM + bj * HALF + wc * 32;
                    f32x4 v0 = acc[ai][bj][m][0] * rs, v1 = acc[ai][bj][m][1] * rs;
                    if (((cbase >> 5) % 3) == 2) {
#pragma unroll
                        for (int e = 0; e < 4; ++e) { const f32x2 cs = rope[pos * 16 + 4 * fq + e]; const float x1 = v0[e], x2 = v1[e]; v0[e] = x1 * cs.x - x2 * cs.y; v1[e] = x2 * cs.x + x1 * cs.y; }
                    }
                    bf16_t* p = qc + (size_t)row * QC_COLS + cbase + 4 * fq;
                    u32x2 w0, w1; w0.x = cvt_pk_bf16(v0[0], v0[1]); w0.y = cvt_pk_bf16(v0[2], v0[3]); w1.x = cvt_pk_bf16(v1[0], v1[1]); w1.y = cvt_pk_bf16(v1[2], v1[3]);
                    *(u32x2*)p = w0; *(u32x2*)(p + 16) = w1; }
                asm volatile("" ::: "memory"); }
    }
};

template <int CTRL> __device__ __forceinline__ float dpp_row_ror(float v) { return __int_as_float(__builtin_amdgcn_update_dpp(0, __float_as_int(v), CTRL, 0xF, 0xF, false)); }
struct EpiGU {
    static constexpr bool PERM = false, AFTER_DRAIN = false;
    bf16_t* Y; const float* ss; const float* cw; const float* cb; float* gf; float* uf; float* gl;
    __device__ __forceinline__ void operator()(const f32x4 (&acc)[2][2][4][2], const Unit& u, int wr, int wc, int fr, int fq) const {
#pragma unroll
        for (int ai = 0; ai < 2; ++ai) {
            const int grp = u.pm * 4 + ai * 2 + wr, rowg = grp * 64;
            float rs[4];
#pragma unroll
            for (int m = 0; m < 4; ++m) rs[m] = rsqrtf(ss[rowg + 16 * m + fr] * (1.0f / DM) + RMS_EPS);
#pragma unroll
            for (int n = 0; n < 2; ++n) {
                const int c = u.pn * HALF + wc * 32 + n * 16 + 4 * fq;
                const f32x4 w0 = *(const f32x4*)(cw + c), w1 = *(const f32x4*)(cw + FF + c), w2 = *(const f32x4*)(cw + 2 * FF + c), bb = *(const f32x4*)(cb + c);
                f32x4 pr1 = {0.f, 0.f, 0.f, 0.f}, pr2 = {0.f, 0.f, 0.f, 0.f};
#pragma unroll
                for (int m = 0; m < 4; ++m) {
                    const f32x4 g0 = acc[ai][0][m][n] * rs[m], u0 = acc[ai][1][m][n] * rs[m];
                    f32x4 r1, r2;
#pragma unroll
                    for (int e2 = 0; e2 < 4; ++e2) { r1[e2] = dpp_row_ror<0x121>(g0[e2]); r2[e2] = dpp_row_ror<0x122>(g0[e2]); }
                    const f32x4 g1 = (fr >= 1) ? r1 : pr1, g2 = (fr >= 2) ? r2 : pr2;
                    pr1 = r1; pr2 = r2;
                    const f32x4 xg = w0 * g2 + w1 * g1 + w2 * g0 + bb; f32x4 y;
#pragma unroll
                    for (int e2 = 0; e2 < 4; ++e2) y[e2] = xg[e2] * __builtin_amdgcn_rcpf(1.0f + __expf(-xg[e2])) * u0[e2];
                    const int row = rowg + 16 * m + fr;
                    if (m > 0 || fr >= 2) { u32x2 w; w.x = cvt_pk_bf16(y[0], y[1]); w.y = cvt_pk_bf16(y[2], y[3]); *(u32x2*)(Y + (size_t)row * FF + c) = w; }
                    if (m == 0) { if (fr < 2) { *(f32x4*)(gf + (size_t)(grp * 2 + fr) * FF + c) = g0; *(f32x4*)(uf + (size_t)(grp * 2 + fr) * FF + c) = u0; } }
                    if (m == 3) { if (fr >= 14) *(f32x4*)(gl + (size_t)(grp * 2 + fr - 14) * FF + c) = g0; }
                }
            }
            asm volatile("" ::: "memory");
        }
    }
};

template <class Epi, class Sched, bool ALIGN_EPI = false, bool SP2 = false>
__device__ __forceinline__ void gemm_phase(PG8_LAS unsigned char* lds, const Gemm g, const Sched& S, const Epi& E) {
    int tid_ = threadIdx.x; asm volatile("" : "+v"(tid_)); const int tid = tid_, wid = __builtin_amdgcn_readfirstlane(tid >> 6), lane = tid & 63, wr = wid >> 2, wc = wid & 3, fr = lane & 15, fq = lane >> 4;
    int K_ = g.K; asm volatile("" : "+s"(K_)); const int K = K_, nt = K / BK;
    unsigned voffA[2], voffB[2];
#pragma unroll
    for (int i = 0; i < 2; ++i) { int R, C; stage_rc(tid * 16 + i * 8192, R, C); const int Rb = Epi::PERM ? ((R & ~31) + perm32(R & 31)) : R;
        voffA[i] = (unsigned)(R * g.lda + C) * 2u; voffB[i] = (unsigned)(Rb * K + C) * 2u; }
    const size_t kstep = (size_t)(BK * 2);
    const size_t hstepB = (size_t)HALF * K * 2, hstepA = (size_t)HALF * g.lda * 2;
    const size_t tstepA = 2 * hstepA, tstepB = 2 * hstepB;
    const unsigned ldsw = (unsigned)wid * 1024u;
    const int aoff = lds_byte(wr * 64 + fr, fq * 8), boff = lds_byte(wc * 32 + fr, fq * 8);
#define PG8_SA(b, h) (((b) * 2 + (h)) * HTB)
#define PG8_SB(b, h) ((4 + (b) * 2 + (h)) * HTB)
#define PG8_STAGE(bufoff, gbase, voff) do { _Pragma("unroll") for (int _i = 0; _i < 2; ++_i) \
        __builtin_amdgcn_global_load_lds((const unsigned*)((const char*)(gbase) + (voff)[_i]), (PG8_LAS unsigned*)(lds + (bufoff) + ldsw + _i * 8192), 16, 0, 0); } while (0)
#define PG8_LDA(dst, b, h) do { _Pragma("unroll") for (int m = 0; m < 4; ++m) _Pragma("unroll") for (int k = 0; k < 2; ++k) dst[m][k] = *(const PG8_LAS bf16x8*)(lds + PG8_SA(b, h) + aoff + m * 2048 + k * 1024); } while (0)
#define PG8_LDB(dst, b, h) do { _Pragma("unroll") for (int n = 0; n < 2; ++n) _Pragma("unroll") for (int k = 0; k < 2; ++k) dst[n][k] = *(const PG8_LAS bf16x8*)(lds + PG8_SB(b, h) + boff + n * 2048 + k * 1024); } while (0)
#define PG8_MMA(ai, bj, At, Bt) do { __builtin_amdgcn_s_setprio(1); _Pragma("unroll") for (int m = 0; m < 4; ++m) _Pragma("unroll") for (int n = 0; n < 2; ++n) _Pragma("unroll") for (int k = 0; k < 2; ++k) \
        acc[ai][bj][m][n] = __builtin_amdgcn_mfma_f32_16x16x32_bf16(Bt[n][k], At[m][k], acc[ai][bj][m][n], 0, 0, 0); __builtin_amdgcn_s_setprio(0); } while (0)
#define PG8_WAIT_V(n) asm volatile("s_waitcnt vmcnt(" #n ")" ::: "memory")
#define PG8_WAIT_L(n) asm volatile("s_waitcnt lgkmcnt(" #n ")" ::: "memory")
#define PG8_BAR __builtin_amdgcn_s_barrier()
#define PG8_SCHED __builtin_amdgcn_sched_barrier(0)
    Unit cur, nxt; int ui = 0;
    if (!S.next(0, cur)) return;
    f32x4 acc[2][2][4][2];
#pragma unroll
    for (int a = 0; a < 2; ++a)
#pragma unroll
        for (int b = 0; b < 2; ++b)
#pragma unroll
            for (int m = 0; m < 4; ++m)
#pragma unroll
                for (int n = 0; n < 2; ++n) acc[a][b][m][n] = (f32x4){0.f, 0.f, 0.f, 0.f};
    bf16x8 At[4][2], B0[2][2], B1[2][2];
    const char* cA = (const char*)g.A + (size_t)cur.pm * tstepA; const char* cB = (const char*)g.Bt + (size_t)cur.pn * tstepB;
    S.a_ready(cur);
    if constexpr (SP2) {
        PG8_STAGE(PG8_SB(0, 0), cB, voffB); PG8_STAGE(PG8_SB(0, 1), cB + hstepB, voffB); PG8_STAGE(PG8_SA(0, 0), cA, voffA); PG8_STAGE(PG8_SA(0, 1), cA + hstepA, voffA);
        if (wr == 1) PG8_BAR;
        PG8_WAIT_V(2); PG8_BAR;
        PG8_STAGE(PG8_SB(1, 0), cB + kstep, voffB); PG8_STAGE(PG8_SA(1, 0), cA + kstep, voffA); PG8_STAGE(PG8_SB(1, 1), cB + hstepB + kstep, voffB);
        PG8_WAIT_V(6); PG8_BAR;
    } else {
        PG8_STAGE(PG8_SB(0, 0), cB, voffB); PG8_STAGE(PG8_SA(0, 0), cA, voffA); PG8_STAGE(PG8_SB(0, 1), cB + hstepB, voffB); PG8_STAGE(PG8_SA(0, 1), cA + hstepA, voffA);
        if (wr == 1) PG8_BAR;
        PG8_WAIT_V(4); PG8_BAR;
        PG8_STAGE(PG8_SB(1, 0), cB + kstep, voffB); PG8_STAGE(PG8_SA(1, 0), cA + kstep, voffA); PG8_STAGE(PG8_SB(1, 1), cB + hstepB + kstep, voffB);
        PG8_WAIT_V(6); PG8_BAR;
    }
    for (;;) {
        const bool has_next = S.next(ui + 1, nxt);
        const char* nA = has_next ? (const char*)g.A + (size_t)nxt.pm * tstepA : cA; const char* nB = has_next ? (const char*)g.Bt + (size_t)nxt.pn * tstepB : cB;
        for (int t = 0; t < nt; t += 2) {
            const bool last = (t == nt - 2);
            const char* a1 = cA + (size_t)(t + 1) * kstep;
            const char* a2 = last ? nA : cA + (size_t)(t + 2) * kstep; const char* b2 = last ? nB : cB + (size_t)(t + 2) * kstep;
            const char* a3 = a2 + kstep; const char* b3 = b2 + kstep;
            if (last && has_next) S.a_ready(nxt);
            if constexpr (SP2) {
            PG8_LDB(B0, 0, 0); PG8_LDB(B1, 0, 1); PG8_SCHED; PG8_LDA(At, 0, 0); PG8_STAGE(PG8_SA(1, 1), a1 + hstepA, voffA);
            PG8_WAIT_V(8); PG8_WAIT_L(0); PG8_BAR; PG8_MMA(0, 0, At, B0); PG8_MMA(0, 1, At, B1); PG8_BAR; PG8_SCHED;
            PG8_LDA(At, 0, 1); PG8_STAGE(PG8_SB(0, 0), b2, voffB); PG8_STAGE(PG8_SB(0, 1), b2 + hstepB, voffB); PG8_STAGE(PG8_SA(0, 0), a2, voffA);
            PG8_WAIT_V(8); PG8_WAIT_L(0); PG8_BAR; PG8_MMA(1, 0, At, B0); PG8_MMA(1, 1, At, B1); PG8_BAR; PG8_SCHED;
            PG8_LDB(B0, 1, 0); PG8_LDB(B1, 1, 1); PG8_SCHED; PG8_LDA(At, 1, 0); PG8_STAGE(PG8_SA(0, 1), a2 + hstepA, voffA);
            PG8_WAIT_V(8); PG8_WAIT_L(0); PG8_BAR; PG8_MMA(0, 0, At, B0); PG8_MMA(0, 1, At, B1); PG8_BAR; PG8_SCHED;
            PG8_LDA(At, 1, 1); PG8_STAGE(PG8_SB(1, 0), b3, voffB); PG8_STAGE(PG8_SB(1, 1), b3 + hstepB, voffB); PG8_STAGE(PG8_SA(1, 0), a3, voffA);
            PG8_WAIT_V(8); PG8_WAIT_L(0); PG8_BAR; PG8_MMA(1, 0, At, B0); PG8_MMA(1, 1, At, B1); PG8_BAR; PG8_SCHED;
            } else {
            PG8_LDB(B0, 0, 0); PG8_SCHED; PG8_LDA(At, 0, 0); PG8_STAGE(PG8_SA(1, 1), a1 + hstepA, voffA);
            PG8_WAIT_L(8); PG8_BAR; PG8_WAIT_L(0); PG8_MMA(0, 0, At, B0); PG8_BAR; PG8_SCHED;
            PG8_LDB(B1, 0, 1); PG8_STAGE(PG8_SB(0, 0), b2, voffB);
            PG8_BAR; PG8_WAIT_L(0); PG8_MMA(0, 1, At, B1); PG8_BAR;
            PG8_LDA(At, 0, 1); PG8_STAGE(PG8_SA(0, 0), a2, voffA);
            PG8_BAR; PG8_WAIT_L(0); PG8_MMA(1, 0, At, B0); PG8_BAR; PG8_SCHED;
            PG8_STAGE(PG8_SB(0, 1), b2 + hstepB, voffB);
            PG8_WAIT_V(6); PG8_BAR; PG8_MMA(1, 1, At, B1); PG8_BAR;
            PG8_LDB(B0, 1, 0); PG8_SCHED; PG8_LDA(At, 1, 0); PG8_STAGE(PG8_SA(0, 1), a2 + hstepA, voffA);
            PG8_WAIT_L(8); PG8_BAR; PG8_WAIT_L(0); PG8_MMA(0, 0, At, B0); PG8_BAR; PG8_SCHED;
            PG8_LDB(B1, 1, 1); PG8_STAGE(PG8_SB(1, 0), b3, voffB);
            PG8_BAR; PG8_WAIT_L(0); PG8_MMA(0, 1, At, B1); PG8_BAR;
            PG8_LDA(At, 1, 1); PG8_STAGE(PG8_SA(1, 0), a3, voffA);
            PG8_BAR; PG8_WAIT_L(0); PG8_MMA(1, 0, At, B0); PG8_BAR; PG8_SCHED;
            PG8_STAGE(PG8_SB(1, 1), b3 + hstepB, voffB);
            PG8_WAIT_V(6); PG8_BAR; PG8_MMA(1, 1, At, B1); PG8_BAR;
            }
        }
        if constexpr (ALIGN_EPI) { if (wr == 0) PG8_BAR; }
        if constexpr (!Epi::AFTER_DRAIN) { E(acc, cur, wr, wc, fr, fq); S.done(cur); }
        if (!has_next) break;
#pragma unroll
        for (int a = 0; a < 2; ++a)
#pragma unroll
            for (int b = 0; b < 2; ++b)
#pragma unroll
                for (int m = 0; m < 4; ++m)
#pragma unroll
                    for (int n = 0; n < 2; ++n) acc[a][b][m][n] = (f32x4){0.f, 0.f, 0.f, 0.f};
        cur = nxt; cA = nA; cB = nB; ++ui;
        if constexpr (ALIGN_EPI) { if (wr == 1) PG8_BAR; }
    }
    PG8_WAIT_V(0);
    if constexpr (!ALIGN_EPI) { if (wr == 0) PG8_BAR; }
    PG8_BAR;
    if constexpr (Epi::AFTER_DRAIN) { E.fused(acc, cur, wr, wc, fr, fq, lds, wid, lane); S.done(cur); }
#undef PG8_SA
#undef PG8_SB
#undef PG8_STAGE
#undef PG8_LDA
#undef PG8_LDB
#undef PG8_MMA
#undef PG8_WAIT_V
#undef PG8_WAIT_L
#undef PG8_BAR
#undef PG8_SCHED
}
}
namespace att {
#define LAS3 __attribute__((address_space(3)))
typedef unsigned short bf16_t;
typedef short bf16x8 __attribute__((ext_vector_type(8)));
typedef short s16x4 __attribute__((ext_vector_type(4)));
typedef float f32x16 __attribute__((ext_vector_type(16)));
typedef float f32x4 __attribute__((ext_vector_type(4)));
typedef unsigned u32x4 __attribute__((ext_vector_type(4)));
typedef unsigned u32x2 __attribute__((ext_vector_type(2)));
constexpr int KBUF = 13312, VBUF = 8192, FBUF = 256, BUFB = KBUF + VBUF + FBUF;
constexpr int TB_OFF = 3 * BUFB, QIDX_OFF = TB_OFF + 1040, FLAG_OFF = QIDX_OFF + 16, ATT_LDS = FLAG_OFF + 16;
constexpr float NEG_BIG = -1.0e30f;

typedef float f32x2_t __attribute__((ext_vector_type(2))); typedef __bf16 bf16x2_t __attribute__((ext_vector_type(2)));
__device__ __forceinline__ unsigned pk2(float lo, float hi) { f32x2_t v = {lo, hi}; bf16x2_t b = __builtin_convertvector(v, bf16x2_t); return __builtin_bit_cast(unsigned, b); }
__device__ __forceinline__ float lane32_other(float v) {
    auto rr = __builtin_amdgcn_permlane32_swap(__float_as_uint(v), __float_as_uint(v), false, false);
    return (__lane_id() & 32) ? __uint_as_float(rr[0]) : __uint_as_float(rr[1]);
}
__device__ __forceinline__ float lane32_max(float v) { auto rr = __builtin_amdgcn_permlane32_swap(__float_as_uint(v), __float_as_uint(v), false, false); return fmaxf(__uint_as_float(rr[0]), __uint_as_float(rr[1])); }
__device__ __forceinline__ float lane32_sum(float v) { auto rr = __builtin_amdgcn_permlane32_swap(__float_as_uint(v), __float_as_uint(v), false, false); return __uint_as_float(rr[0]) + __uint_as_float(rr[1]); }
__device__ __forceinline__ s16x4 vtr(const LAS3 unsigned char* p) { typedef short v4i16_t __attribute__((ext_vector_type(4))); return __builtin_bit_cast(s16x4, __builtin_amdgcn_ds_read_tr16_b64_v4i16((LAS3 v4i16_t*)p)); }

struct Ptrs {
    const bf16_t* Q; int qp, qh;
    const bf16_t* K; int kp, kh;
    const bf16_t* K2; int k2p;
    const bf16_t* V; int vp, vh;
    bf16_t* O; int oc;
    const float* bias;
    const float* kmax;
};

template <int VAR>
__device__ __forceinline__ void attn_unit(const Ptrs& P, int b, int h, int qb, LAS3 unsigned char* lds) {
    constexpr int DQ = (VAR == 2) ? 96 : 64, ND = DQ / 16, KP = DQ * 2 + 16;
    constexpr bool DESC = (VAR == 1 || VAR == 3);
    int tid_ = threadIdx.x; asm volatile("" : "+v"(tid_)); const int tid = tid_, lane = tid & 63, r32 = lane & 31, hi = lane >> 5; const int wid = __builtin_amdgcn_readfirstlane(tid >> 6);
    const size_t rowbase = (size_t)b * SEQ; const int q0 = qb * 256, qrow = q0 + wid * 32 + r32;
    const int cw = 4 * qb + (wid >> 1);
    const int t_hi = 4 * qb + 3, t_lo = (VAR == 0) ? ((4 * qb - 8) > 0 ? (4 * qb - 8) : 0) : 0, nt = t_hi - t_lo + 1;
    const int w_lo = (VAR == 0) ? ((cw - 8) > 0 ? (cw - 8) : 0) : 0, w_hi = cw;
    LAS3 float* TB = (LAS3 float*)(lds + TB_OFF);
    if (VAR == 0) { for (int i = tid; i < 257; i += 512) TB[i] = P.bias[h * 257 + i] * LOG2E; }
    volatile LAS3 unsigned* donec = (volatile LAS3 unsigned*)(lds + FLAG_OFF);
    bool wdone = false; int dp = 0;
    if (DESC) { if (tid == 0) donec[0] = 0u; }
    bf16x8 qf[ND];
    { const bf16_t* qp = P.Q + (rowbase + qrow) * P.qp + h * P.qh + hi * 8;
#pragma unroll
      for (int d0 = 0; d0 < ND; ++d0) qf[d0] = *(const bf16x8*)(qp + d0 * 16); }
    float qk_bound = 0.f;
    if (VAR == 3) { float s2_ = 0.f;
#pragma unroll
        for (int d0 = 0; d0 < ND; ++d0)
#pragma unroll
            for (int e = 0; e < 8; ++e) { const float v_ = __uint_as_float(((unsigned)(unsigned short)qf[d0][e]) << 16); s2_ += v_ * v_; }
        s2_ = lane32_sum(s2_); qk_bound = sqrtf(s2_) * P.kmax[b * 8 + h] * 1.001f; }
    const int lkey = tid >> 3, lj = tid & 7;
    const bf16_t* kg = P.K + (rowbase + lkey) * P.kp + h * P.kh + lj * 8;
    const bf16_t* vg = P.V + (rowbase + lkey) * P.vp + h * P.vh + lj * 8;
    const bf16_t* k2g = (VAR == 2) ? P.K2 + (rowbase + (tid >> 2)) * P.k2p + (tid & 3) * 8 : nullptr;
    const float* fg = (VAR == 3) ? P.bias + ((size_t)(b * 8 + h)) * SEQ + (tid & 15) * 4 : nullptr;
    const int kw = lkey * KP + lj * 16, vw = KBUF + (lj >> 2) * 4096 + lkey * 64 + (lj & 3) * 16, k2w = (tid >> 2) * KP + 128 + (tid & 3) * 16, fw = KBUF + VBUF + (tid & 15) * 16;
    u32x4 rk, rv, rk2; f32x4 rf;
#define ATT_LOAD(t) do { const size_t ko_ = (size_t)(t) * 64; rk = *(const u32x4*)(kg + ko_ * P.kp); rv = *(const u32x4*)(vg + ko_ * P.vp); \
        if (VAR == 2) { if (tid < 256) rk2 = *(const u32x4*)(k2g + ko_ * P.k2p); } if (VAR == 3) { if (tid < 16) rf = *(const f32x4*)(fg + ko_); } } while (0)
#define ATT_STORE(bufo) do { *(LAS3 u32x4*)(lds + (bufo) + kw) = rk; *(LAS3 u32x4*)(lds + (bufo) + vw) = rv; \
        if (VAR == 2) { if (tid < 256) *(LAS3 u32x4*)(lds + (bufo) + k2w) = rk2; } if (VAR == 3) { if (tid < 16) *(LAS3 f32x4*)(lds + (bufo) + fw) = rf; } } while (0)
    const int pi = (r32 & ~12) | ((r32 & 4) << 1) | ((r32 & 8) >> 1);
    const int ka = pi * KP + hi * 16;
    const int va = KBUF + (8 * hi + ((lane & 15) >> 2)) * 64 + (16 * ((lane >> 4) & 1) + 4 * (lane & 3)) * 2;
    float m_run = NEG_BIG, l_run = 0.f, R = 0.f;
    f32x16 ot0 = {}, ot1 = {};
    { const int t0 = DESC ? t_hi : t_lo; ATT_LOAD(t0); ATT_STORE(0); }
    __syncthreads();
    for (int it = 0; it < nt; ++it) {
        const int t = DESC ? (t_hi - it) : (t_lo + it);
        const int bufo = (it & 1) * BUFB, nbufo = BUFB - bufo;
        const bool more = (it + 1 < nt);
        if (more) { const int tn = DESC ? (t - 1) : (t + 1); ATT_LOAD(tn); }
        if (DESC) { if (tid == 0) donec[dp == 2 ? 0 : dp + 1] = 0u; }
        if (t >= w_lo && t <= w_hi && !(DESC && wdone)) {
            f32x16 sa = {}, sb = {};
            const LAS3 unsigned char* kb = lds + bufo + ka;
#pragma unroll
            for (int d0 = 0; d0 < ND; ++d0) {
                const bf16x8 k0 = *(const LAS3 bf16x8*)(kb + d0 * 32), k1 = *(const LAS3 bf16x8*)(kb + 32 * KP + d0 * 32);
                sa = __builtin_amdgcn_mfma_f32_32x32x16_bf16(k0, qf[d0], sa, 0, 0, 0);
                sb = __builtin_amdgcn_mfma_f32_32x32x16_bf16(k1, qf[d0], sb, 0, 0, 0);
            }
            bf16x8 pk[4];
            if (VAR != 1) {
                if (VAR == 0) {
                    if (cw - t >= 3) { const float c = TB[256];
#pragma unroll
                        for (int r = 0; r < 16; ++r) { sa[r] += c; sb[r] += c; } }
                    else { const int d0_ = qrow - 64 * t - 8 * hi + 128;
#pragma unroll
                        for (int r = 0; r < 16; ++r) { int ia = d0_ - 16 * (r >> 3) - (r & 7), ib = ia - 32; ia = ia < 0 ? 0 : (ia > 256 ? 256 : ia); ib = ib < 0 ? 0 : (ib > 256 ? 256 : ib);
                            sa[r] += TB[ia]; sb[r] += TB[ib]; } }
                }
                if (VAR == 3) {
                    const LAS3 float* F = (const LAS3 float*)(lds + bufo + KBUF + VBUF) + 8 * hi;
#pragma unroll
                    for (int a = 0; a < 2; ++a) {
                        const f32x4 fa0 = *(const LAS3 f32x4*)(F + 16 * a), fa1 = *(const LAS3 f32x4*)(F + 16 * a + 4), fb0 = *(const LAS3 f32x4*)(F + 32 + 16 * a), fb1 = *(const LAS3 f32x4*)(F + 32 + 16 * a + 4);
#pragma unroll
                        for (int e = 0; e < 4; ++e) { sa[8 * a + e] -= fa0[e]; sa[8 * a + 4 + e] -= fa1[e]; sb[8 * a + e] -= fb0[e]; sb[8 * a + 4 + e] -= fb1[e]; }
                    }
                    if (t == cw) { const int lim = qrow - 64 * t - 8 * hi;
#pragma unroll
                        for (int r = 0; r < 16; ++r) { const int kk = 16 * (r >> 3) + (r & 7); if (kk > lim) sa[r] = NEG_BIG; if (kk + 32 > lim) sb[r] = NEG_BIG; } }
                }
                float mx = fmaxf(sa[0], sb[0]);
#pragma unroll
                for (int r = 1; r < 16; ++r) mx = fmaxf(mx, fmaxf(sa[r], sb[r]));
                mx = lane32_max(mx);
                const float m_new = fmaxf(m_run, mx), alpha = __builtin_amdgcn_exp2f(m_run - m_new); m_run = m_new;
                float ls = 0.f;
#pragma unroll
                for (int r = 0; r < 16; ++r) { sa[r] = __builtin_amdgcn_exp2f(sa[r] - m_new); sb[r] = __builtin_amdgcn_exp2f(sb[r] - m_new); ls += sa[r] + sb[r]; }
                l_run = l_run * alpha + ls;
#pragma unroll
                for (int r = 0; r < 16; ++r) { ot0[r] *= alpha; ot1[r] *= alpha; }
                if (VAR == 3) {
                    const float f0_ = *((const LAS3 float*)(lds + bufo + KBUF + VBUF));
                    if (__all(qk_bound - f0_ - m_run < -160.0f) || t == 0) wdone = true;
                }
            } else {
                const int lim = (t == cw) ? (qrow - 64 * t - 8 * hi) : 1000;
                float seg[4];
#pragma unroll
                for (int a = 0; a < 4; ++a) { float run = 0.f;
#pragma unroll
                    for (int j = 7; j >= 0; --j) { const int r = 8 * (a & 1) + j; const float z = (a < 2) ? sa[r] : sb[r]; const int kk = 16 * a + j;
                        const float sp = fmaxf(z, 0.f) + __logf(1.0f + __expf(-fabsf(z)));
                        const bool vis = kk < lim;
                        const float lb = z - sp + run;
                        if (a < 2) sa[r] = vis ? lb : NEG_BIG; else sb[r] = vis ? lb : NEG_BIG;
                        run += vis ? -sp : 0.f; }
                    seg[a] = run; }
                float oth[4];
#pragma unroll
                for (int a = 0; a < 4; ++a) oth[a] = lane32_other(seg[a]);
                float off[4]; float accu = R;
#pragma unroll
                for (int a = 3; a >= 0; --a) { if (hi) { off[a] = accu; accu += seg[a] + oth[a]; } else { off[a] = accu + oth[a]; accu += seg[a] + oth[a]; } }
                R = accu;
                if (__all(R < -105.0f) || t == 0) wdone = true;
#pragma unroll
                for (int r = 0; r < 8; ++r) { sa[r] = __expf(sa[r] + off[0]); sa[8 + r] = __expf(sa[8 + r] + off[1]); sb[r] = __expf(sb[r] + off[2]); sb[8 + r] = __expf(sb[8 + r] + off[3]); }
            }
            { u32x4 w;
              w.x = pk2(sa[0], sa[1]); w.y = pk2(sa[2], sa[3]); w.z = pk2(sa[4], sa[5]); w.w = pk2(sa[6], sa[7]); pk[0] = __builtin_bit_cast(bf16x8, w);
              w.x = pk2(sa[8], sa[9]); w.y = pk2(sa[10], sa[11]); w.z = pk2(sa[12], sa[13]); w.w = pk2(sa[14], sa[15]); pk[1] = __builtin_bit_cast(bf16x8, w);
              w.x = pk2(sb[0], sb[1]); w.y = pk2(sb[2], sb[3]); w.z = pk2(sb[4], sb[5]); w.w = pk2(sb[6], sb[7]); pk[2] = __builtin_bit_cast(bf16x8, w);
              w.x = pk2(sb[8], sb[9]); w.y = pk2(sb[10], sb[11]); w.z = pk2(sb[12], sb[13]); w.w = pk2(sb[14], sb[15]); pk[3] = __builtin_bit_cast(bf16x8, w); }
            const LAS3 unsigned char* vb = lds + bufo + va;
#pragma unroll
            for (int s = 0; s < 4; ++s) {
                const s16x4 a0 = vtr(vb + s * 1024), a1 = vtr(vb + s * 1024 + 256), c0 = vtr(vb + 4096 + s * 1024), c1 = vtr(vb + 4096 + s * 1024 + 256);
                const bf16x8 v0 = {a0[0], a0[1], a0[2], a0[3], a1[0], a1[1], a1[2], a1[3]}, v1 = {c0[0], c0[1], c0[2], c0[3], c1[0], c1[1], c1[2], c1[3]};
                ot0 = __builtin_amdgcn_mfma_f32_32x32x16_bf16(v0, pk[s], ot0, 0, 0, 0);
                ot1 = __builtin_amdgcn_mfma_f32_32x32x16_bf16(v1, pk[s], ot1, 0, 0, 0);
            }
        }
        if (more) ATT_STORE(nbufo);
        if (DESC) { if (wdone && lane == 0) __hip_atomic_fetch_add((LAS3 unsigned*)(lds + FLAG_OFF) + dp, 1u, __ATOMIC_RELAXED, __HIP_MEMORY_SCOPE_WORKGROUP); }
        __syncthreads();
        if (DESC) { if (donec[dp] == 8u) break; dp = (dp == 2) ? 0 : dp + 1; }
    }
#undef ATT_LOAD
#undef ATT_STORE
    float inv = 1.f;
    if (VAR != 1) { const float lt = lane32_sum(l_run); inv = 1.0f / lt; }
    bf16_t* op = P.O + (rowbase + qrow) * DM + P.oc + h * 64 + 4 * hi;
#pragma unroll
    for (int a = 0; a < 4; ++a) {
        u32x2 w0, w1; w0.x = pk2(ot0[4 * a] * inv, ot0[4 * a + 1] * inv); w0.y = pk2(ot0[4 * a + 2] * inv, ot0[4 * a + 3] * inv);
        w1.x = pk2(ot1[4 * a] * inv, ot1[4 * a + 1] * inv); w1.y = pk2(ot1[4 * a + 2] * inv, ot1[4 * a + 3] * inv);
        *(u32x2*)(op + 8 * a) = w0; *(u32x2*)(op + 32 + 8 * a) = w1;
    }
}

template <int VAR>
__device__ __forceinline__ void attn_unit_sm(const Ptrs& P, int b, int h, int qb, LAS3 unsigned char* lds) {
    constexpr int DQ = (VAR == 2) ? 96 : 64, ND = DQ / 16, KP = DQ * 2 + 16;
    int tid_ = threadIdx.x; asm volatile("" : "+v"(tid_)); const int tid = tid_, lane = tid & 63, r32 = lane & 31, hi = lane >> 5; const int wid = __builtin_amdgcn_readfirstlane(tid >> 6);
    const size_t rowbase = (size_t)b * SEQ; const int q0 = qb * 256, qrow = q0 + wid * 32 + r32;
    const int cw = 4 * qb + (wid >> 1);
    const int t_hi = 4 * qb + 3, t_lo = (VAR == 0) ? ((4 * qb - 8) > 0 ? (4 * qb - 8) : 0) : 0, nt = t_hi - t_lo + 1;
    const int w_lo = (VAR == 0) ? ((cw - 8) > 0 ? (cw - 8) : 0) : 0, w_hi = cw;
    LAS3 float* TB = (LAS3 float*)(lds + TB_OFF);
    if (VAR == 0) { for (int i = tid; i < 257; i += 512) TB[i] = P.bias[h * 257 + i] * LOG2E; }
    bf16x8 qf[ND];
    { const bf16_t* qp = P.Q + (rowbase + qrow) * P.qp + h * P.qh + hi * 8;
#pragma unroll
      for (int d0 = 0; d0 < ND; ++d0) qf[d0] = *(const bf16x8*)(qp + d0 * 16); }
    const float cbase = (VAR == 3) ? P.bias[((size_t)(b * 8 + h)) * SEQ + qrow] : 0.f;
    const int lkey = tid >> 3, lj = tid & 7;
    const bf16_t* kg = P.K + (rowbase + lkey) * P.kp + h * P.kh + lj * 8;
    const bf16_t* vg = P.V + (rowbase + lkey) * P.vp + h * P.vh + lj * 8;
    const bf16_t* k2g = (VAR == 2) ? P.K2 + (rowbase + (tid >> 2)) * P.k2p + (tid & 3) * 8 : nullptr;
    const float* fg = (VAR == 3) ? P.bias + ((size_t)(b * 8 + h)) * SEQ + (tid & 15) * 4 : nullptr;
    const int kw = lkey * KP + lj * 16, vw = KBUF + (lj >> 2) * 4096 + lkey * 64 + (lj & 3) * 16, k2w = (tid >> 2) * KP + 128 + (tid & 3) * 16, fw = KBUF + VBUF + (tid & 15) * 16;
    u32x4 rk0, rv0, rk20, rk1, rv1, rk21; f32x4 rf0, rf1;
#define ATT_LOAD(t, S) do { const size_t ko_ = (size_t)(t) * 64; rk##S = *(const u32x4*)(kg + ko_ * P.kp); rv##S = *(const u32x4*)(vg + ko_ * P.vp); \
        if (VAR == 2) { if (tid < 256) rk2##S = *(const u32x4*)(k2g + ko_ * P.k2p); } if (VAR == 3) { if (tid < 16) rf##S = *(const f32x4*)(fg + ko_); } } while (0)
#define ATT_STORE(bufo, S) do { *(LAS3 u32x4*)(lds + (bufo) + kw) = rk##S; *(LAS3 u32x4*)(lds + (bufo) + vw) = rv##S; \
        if (VAR == 2) { if (tid < 256) *(LAS3 u32x4*)(lds + (bufo) + k2w) = rk2##S; } if (VAR == 3) { if (tid < 16) *(LAS3 f32x4*)(lds + (bufo) + fw) = rf##S; } } while (0)
    const int pi = (r32 & ~12) | ((r32 & 4) << 1) | ((r32 & 8) >> 1);
    const int ka = pi * KP + hi * 16;
    const int va = KBUF + (8 * hi + ((lane & 15) >> 2)) * 64 + (16 * ((lane >> 4) & 1) + 4 * (lane & 3)) * 2;
    float m_run = 0.f, l_run = 0.f;
    f32x16 ot0 = {}, ot1 = {}, negm;
#pragma unroll
    for (int r = 0; r < 16; ++r) negm[r] = cbase;
    asm volatile("" : "+v"(negm));
    f32x16 sA0 = {}, sA1 = {}, sB0 = {}, sB1 = {};
#define SM_QK(SA, SB, kbo) do { const LAS3 unsigned char* kb_ = lds + (kbo) + ka; __builtin_amdgcn_s_setprio(1); \
        _Pragma("unroll") for (int d0 = 0; d0 < ND; ++d0) { \
            const bf16x8 k0_ = *(const LAS3 bf16x8*)(kb_ + d0 * 32), k1_ = *(const LAS3 bf16x8*)(kb_ + 32 * KP + d0 * 32); \
            if (d0 == 0) { SA = __builtin_amdgcn_mfma_f32_32x32x16_bf16(k0_, qf[0], negm, 0, 0, 0); SB = __builtin_amdgcn_mfma_f32_32x32x16_bf16(k1_, qf[0], negm, 0, 0, 0); } \
            else { SA = __builtin_amdgcn_mfma_f32_32x32x16_bf16(k0_, qf[d0], SA, 0, 0, 0); SB = __builtin_amdgcn_mfma_f32_32x32x16_bf16(k1_, qf[d0], SB, 0, 0, 0); } } __builtin_amdgcn_s_setprio(0); } while (0)
#define SM_BIAS(SA, SB, tn, bo) do { \
        if (VAR == 0) { \
            if (cw - (tn) >= 3) { const float c_ = TB[256]; _Pragma("unroll") for (int r = 0; r < 16; ++r) { SA[r] += c_; SB[r] += c_; } } \
            else { const int d0_ = qrow - 64 * (tn) - 8 * hi + 128; \
                _Pragma("unroll") for (int r = 0; r < 16; ++r) { int ia = d0_ - 16 * (r >> 3) - (r & 7), ib = ia - 32; ia = ia < 0 ? 0 : (ia > 256 ? 256 : ia); ib = ib < 0 ? 0 : (ib > 256 ? 256 : ib); \
                    SA[r] += TB[ia]; SB[r] += TB[ib]; } } } \
        if (VAR == 3) { const LAS3 float* F_ = (const LAS3 float*)(lds + (bo) + KBUF + VBUF) + 8 * hi; \
            _Pragma("unroll") for (int a = 0; a < 2; ++a) { \
                const f32x4 fa0 = *(const LAS3 f32x4*)(F_ + 16 * a), fa1 = *(const LAS3 f32x4*)(F_ + 16 * a + 4), fb0 = *(const LAS3 f32x4*)(F_ + 32 + 16 * a), fb1 = *(const LAS3 f32x4*)(F_ + 32 + 16 * a + 4); \
                _Pragma("unroll") for (int e = 0; e < 4; ++e) { SA[8 * a + e] -= fa0[e]; SA[8 * a + 4 + e] -= fa1[e]; SB[8 * a + e] -= fb0[e]; SB[8 * a + 4 + e] -= fb1[e]; } } \
            if ((tn) >= cw) { const int lim_ = qrow - 64 * (tn) - 8 * hi; \
                _Pragma("unroll") for (int r = 0; r < 16; ++r) { const int kk = 16 * (r >> 3) + (r & 7); if (kk > lim_) SA[r] = NEG_BIG; if (kk + 32 > lim_) SB[r] = NEG_BIG; } } } } while (0)
#define SM_BIAS_C(SA, SB, tn) do { if (VAR == 2) { if ((tn) > cw) { _Pragma("unroll") for (int r = 0; r < 16; ++r) { SA[r] = NEG_BIG; SB[r] = NEG_BIG; } } } } while (0)
#define SM_REF(SA, SB, HASN, NA, NB) do { \
        float mx_ = fmaxf(SA[0], SB[0]); _Pragma("unroll") for (int r = 1; r < 16; ++r) mx_ = fmaxf(mx_, fmaxf(SA[r], SB[r])); \
        mx_ = lane32_max(mx_); \
        if (__any(mx_ > 8.0f)) { const float dl_ = fmaxf(mx_, 0.f); m_run += dl_; \
            _Pragma("unroll") for (int r = 0; r < 16; ++r) { SA[r] -= dl_; SB[r] -= dl_; } \
            if (HASN) { _Pragma("unroll") for (int r = 0; r < 16; ++r) { NA[r] -= dl_; NB[r] -= dl_; } } \
            const float nm_ = cbase - m_run; _Pragma("unroll") for (int r = 0; r < 16; ++r) negm[r] = nm_; asm volatile("" : "+v"(negm)); \
            { const float f_ = __builtin_amdgcn_exp2f(-dl_); l_run *= f_; _Pragma("unroll") for (int r = 0; r < 16; ++r) { ot0[r] *= f_; ot1[r] *= f_; } } } } while (0)
#define SM_PV(SA, SB, vbo) do { const LAS3 unsigned char* vb_ = lds + (vbo) + va; float ls_ = 0.f; \
        _Pragma("unroll") for (int s = 0; s < 4; ++s) { u32x4 w_; \
            _Pragma("unroll") for (int j = 0; j < 4; ++j) { float e0_, e1_; \
                if (s < 2) { e0_ = __builtin_amdgcn_exp2f(SA[8 * (s & 1) + 2 * j]); e1_ = __builtin_amdgcn_exp2f(SA[8 * (s & 1) + 2 * j + 1]); } \
                else { e0_ = __builtin_amdgcn_exp2f(SB[8 * (s & 1) + 2 * j]); e1_ = __builtin_amdgcn_exp2f(SB[8 * (s & 1) + 2 * j + 1]); } \
                ls_ += e0_ + e1_; w_[j] = pk2(e0_, e1_); } \
            const bf16x8 p_ = __builtin_bit_cast(bf16x8, w_); \
            const s16x4 a0 = vtr(vb_ + s * 1024), a1 = vtr(vb_ + s * 1024 + 256), c0 = vtr(vb_ + 4096 + s * 1024), c1 = vtr(vb_ + 4096 + s * 1024 + 256); \
            const bf16x8 v0 = {a0[0], a0[1], a0[2], a0[3], a1[0], a1[1], a1[2], a1[3]}, v1 = {c0[0], c0[1], c0[2], c0[3], c1[0], c1[1], c1[2], c1[3]}; \
            ot0 = __builtin_amdgcn_mfma_f32_32x32x16_bf16(v0, p_, ot0, 0, 0, 0); \
            ot1 = __builtin_amdgcn_mfma_f32_32x32x16_bf16(v1, p_, ot1, 0, 0, 0); } \
        l_run += ls_; } while (0)
#define SM_STEP(CA, CB, NA, NB, it, LS, SS) do { \
        const bool more_ = ((it) + 2 < nt); \
        if ((it) + 3 < nt) ATT_LOAD((it) + 3, LS); \
        SM_REF(CA, CB, false, NA, NB); SM_QK(NA, NB, b_next); SM_PV(CA, CB, b_cur); SM_BIAS(NA, NB, (it) + 1, b_next); SM_BIAS_C(NA, NB, (it) + 1); \
        if (more_) ATT_STORE(b_store, SS); \
        asm volatile("s_waitcnt lgkmcnt(0)\n\ts_barrier" ::: "memory");     \
        { const int tb_ = b_cur; b_cur = b_next; b_next = b_store; b_store = tb_; } } while (0)
    ATT_LOAD(0, 0); ATT_LOAD(1, 1); ATT_STORE(0, 0); ATT_STORE(BUFB, 1); ATT_LOAD(2, 1);
    __syncthreads();
    int b_cur = 0, b_next = BUFB, b_store = 2 * BUFB;
    SM_QK(sA0, sA1, 0); SM_BIAS(sA0, sA1, 0, 0);
    { float mx_ = fmaxf(sA0[0], sA1[0]);
#pragma unroll
      for (int r = 1; r < 16; ++r) mx_ = fmaxf(mx_, fmaxf(sA0[r], sA1[r]));
      mx_ = lane32_max(mx_); m_run = mx_;
#pragma unroll
      for (int r = 0; r < 16; ++r) { sA0[r] -= mx_; sA1[r] -= mx_; negm[r] = cbase - mx_; }
      asm volatile("" : "+v"(negm)); }
    int it = 0;
    for (; it + 2 < nt; it += 2) {
        SM_STEP(sA0, sA1, sB0, sB1, it, 0, 1);
        SM_STEP(sB0, sB1, sA0, sA1, it + 1, 1, 0);
    }
    SM_STEP(sA0, sA1, sB0, sB1, it, 0, 1);
    SM_REF(sB0, sB1, false, sA0, sA1); SM_PV(sB0, sB1, b_cur);
    __syncthreads();
#undef SM_STEP
#undef SM_PV
#undef SM_REF
#undef SM_BIAS
#undef SM_BIAS_C
#undef SM_QK
#undef ATT_LOAD
#undef ATT_STORE
    const float lt = lane32_sum(l_run); const float inv = 1.0f / lt;
    bf16_t* op = P.O + (rowbase + qrow) * DM + P.oc + h * 64 + 4 * hi;
#pragma unroll
    for (int a = 0; a < 4; ++a) {
        u32x2 w0, w1; w0.x = pk2(ot0[4 * a] * inv, ot0[4 * a + 1] * inv); w0.y = pk2(ot0[4 * a + 2] * inv, ot0[4 * a + 3] * inv);
        w1.x = pk2(ot1[4 * a] * inv, ot1[4 * a + 1] * inv); w1.y = pk2(ot1[4 * a + 2] * inv, ot1[4 * a + 3] * inv);
        *(u32x2*)(op + 8 * a) = w0; *(u32x2*)(op + 32 + 8 * a) = w1;
    }
}
}
#define LAS __attribute__((address_space(3)))
typedef unsigned short bf16;
typedef unsigned v4u __attribute__((ext_vector_type(4)));
typedef float f32x4 __attribute__((ext_vector_type(4)));
typedef float f32x2 __attribute__((ext_vector_type(2)));
constexpr int NWAVES = 8, NTHR = 512;
constexpr size_t MiB = 1u << 20;
constexpr size_t WS_SS = 0;
constexpr size_t WS_QCTR = 7 * 131072;
constexpr size_t WS_BAR = WS_QCTR + 64 * 256;
constexpr size_t WS_KMAX = WS_BAR + 3456 * 4;
constexpr size_t WS_ROPE = 1 * MiB;
constexpr size_t WS_LF = 2 * MiB;
constexpr size_t WS_CUMF = 3 * MiB;
constexpr size_t WS_W_AB = 4 * MiB, WS_W_OAB = 10 * MiB, WS_W_GU0 = 12 * MiB, WS_W_DN0 = 23 * MiB, WS_W_CD = 29 * MiB, WS_W_UQ = 34 * MiB, WS_W_UKV = 35 * MiB,
                 WS_W_OCD = 36 * MiB, WS_W_GU1 = 38 * MiB, WS_W_DN1 = 49 * MiB;
constexpr size_t WS_XB = 56 * MiB;
constexpr size_t WS_BIG = 120 * MiB;
constexpr size_t WS_END = 472 * MiB;
constexpr int RING_BYTES = 131072, LDS_BYTES = 147456;

struct Args {
    const float *x, *ab_norm, *ab_w_in, *ab_rel_bias, *ab_w_o, *cd_norm, *cd_w_in, *cd_q_norm, *cd_w_uq, *cd_kv_norm, *cd_w_ukv, *cd_b_f, *cd_w_o,
                *ffn_norm, *ffn_w_gate, *ffn_w_up, *ffn_conv_w, *ffn_conv_b, *ffn_w_down, *final_norm;
    float* out; unsigned char* ws;
};

__device__ __forceinline__ unsigned f2bf(float f) { unsigned u = __builtin_bit_cast(unsigned, f); return (u + 0x7fffu + ((u >> 16) & 1u)) >> 16; }
__device__ __forceinline__ unsigned pk2f(float lo, float hi) { return f2bf(lo) | (f2bf(hi) << 16); }
__device__ __forceinline__ float bf_lo(unsigned w) { return __uint_as_float(w << 16); }
__device__ __forceinline__ float bf_hi(unsigned w) { return __uint_as_float(w & 0xffff0000u); }
__device__ __forceinline__ float wave_sum(float v) {
#pragma unroll
    for (int o = 1; o < 64; o <<= 1) v += __shfl_xor(v, o);
    return v;
}

struct WDesc { const float* W; int K, N, Npad; bf16* WT; int row_off; int ilv; const float* gain; int s0lo, s0hi; float s0; int s1lo, s1hi; float s1; };
__device__ __forceinline__ void transpose_item(const WDesc& d, LAS float* scr, int item, int lane) {
    const int nblk = d.Npad / 32, kb = item / nblk, nb = item % nblk, k0 = 64 * kb, n0 = 32 * nb;
    const int n = n0 + (lane & 31);
    const float cs = (n >= d.s0lo && n < d.s0hi) ? d.s0 : ((n >= d.s1lo && n < d.s1hi) ? d.s1 : 1.0f);
    float wv[32];
#pragma unroll
    for (int i = 0; i < 32; ++i) { const int kk = 2 * i + (lane >> 5); wv[i] = (n < d.N) ? d.W[(size_t)(k0 + kk) * d.N + n] : 0.f; }
    const float g0 = d.gain ? d.gain[k0 + lane] : 1.0f;
#pragma unroll
    for (int i = 0; i < 32; ++i) { const int kk = 2 * i + (lane >> 5); const float g = __shfl(g0, kk); scr[kk * 33 + (lane & 31)] = wv[i] * g * cs; }
    asm volatile("s_waitcnt lgkmcnt(0)" ::: "memory");
    const int c = lane & 7;
#pragma unroll
    for (int j = 0; j < 4; ++j) { const int nn = (lane >> 3) + 8 * j; const LAS float* s = scr + (8 * c) * 33 + nn;
        v4u o; o.x = pk2f(s[0 * 33], s[1 * 33]); o.y = pk2f(s[2 * 33], s[3 * 33]); o.z = pk2f(s[4 * 33], s[5 * 33]); o.w = pk2f(s[6 * 33], s[7 * 33]);
        const int rowb = d.ilv ? (256 * (n0 >> 7) + (n0 & 127) + d.row_off) : (d.row_off + n0);
        *(v4u*)(d.WT + (size_t)(rowb + nn) * d.K + k0 + 8 * c) = o; }
    asm volatile("s_waitcnt lgkmcnt(0)" ::: "memory");
}
__device__ __forceinline__ WDesc wdesc(const Args& a, int mi) {
    unsigned char* ws = a.ws; WDesc d; d.gain = nullptr; d.row_off = 0; d.ilv = 0; d.s0lo = d.s0hi = d.s1lo = d.s1hi = 0; d.s0 = d.s1 = 1.f;
    switch (mi) {
    case 0: d.W = a.ab_w_in; d.K = DM; d.N = AB_COLS; d.Npad = AB_COLS; d.WT = (bf16*)(ws + WS_W_AB); d.gain = a.ab_norm; d.s0lo = 0; d.s0hi = 512; d.s0 = 0.125f * LOG2E; d.s1lo = 1536; d.s1hi = 2048; d.s1 = 0.125f; break;
    case 1: d.W = a.ab_w_o; d.K = DM; d.N = DM; d.Npad = DM; d.WT = (bf16*)(ws + WS_W_OAB); break;
    case 2: d.W = a.ffn_w_gate; d.K = DM; d.N = FF; d.Npad = FF; d.WT = (bf16*)(ws + WS_W_GU0); d.gain = a.ffn_norm; d.ilv = 1; break;
    case 3: d.W = a.ffn_w_up; d.K = DM; d.N = FF; d.Npad = FF; d.WT = (bf16*)(ws + WS_W_GU0); d.row_off = 128; d.ilv = 1; d.gain = a.ffn_norm; break;
    case 4: d.W = a.ffn_w_down; d.K = FF; d.N = DM; d.Npad = DM; d.WT = (bf16*)(ws + WS_W_DN0); break;
    case 5: d.W = a.cd_w_in; d.K = DM; d.N = CD_COLS; d.Npad = CD_PAD; d.WT = (bf16*)(ws + WS_W_CD); d.gain = a.cd_norm; d.s0lo = 672; d.s0hi = 1184; d.s0 = 0.125f * LOG2E; break;
    case 6: d.W = a.cd_w_uq; d.K = Q_RANK; d.N = QC_COLS; d.Npad = QC_COLS; d.WT = (bf16*)(ws + WS_W_UQ); d.gain = a.cd_q_norm; d.s0lo = 0; d.s0hi = QC_COLS; d.s0 = 0.10206207261596575f * LOG2E; break;
    case 7: d.W = a.cd_w_ukv; d.K = KV_RANK; d.N = KVC_COLS; d.Npad = KVC_COLS; d.WT = (bf16*)(ws + WS_W_UKV); d.gain = a.cd_kv_norm; break;
    case 8: d.W = a.cd_w_o; d.K = DM; d.N = DM; d.Npad = DM; d.WT = (bf16*)(ws + WS_W_OCD); break;
    case 9: d.W = a.ffn_w_gate + (size_t)DM * FF; d.K = DM; d.N = FF; d.Npad = FF; d.WT = (bf16*)(ws + WS_W_GU1); d.gain = a.ffn_norm + DM; d.ilv = 1; break;
    case 10: d.W = a.ffn_w_up + (size_t)DM * FF; d.K = DM; d.N = FF; d.Npad = FF; d.WT = (bf16*)(ws + WS_W_GU1); d.row_off = 128; d.ilv = 1; d.gain = a.ffn_norm + DM; break;
    default: d.W = a.ffn_w_down + (size_t)FF * DM; d.K = FF; d.N = DM; d.Npad = DM; d.WT = (bf16*)(ws + WS_W_DN1); break;
    }
    return d;
}
__device__ __forceinline__ int witems(int mi) {
    switch (mi) { case 0: return (DM / 64) * (AB_COLS / 32); case 1: case 8: return (DM / 64) * (DM / 32); case 2: case 3: case 9: case 10: return (DM / 64) * (FF / 32);
                  case 4: case 11: return (FF / 64) * (DM / 32); case 5: return (DM / 64) * (CD_PAD / 32); case 6: return (Q_RANK / 64) * (QC_COLS / 32); default: return (KV_RANK / 64) * (KVC_COLS / 32); }
}

__device__ __forceinline__ void p0_prologue(const Args& a, LAS unsigned char* lds, int gw, int NGW, int lane, int wave) {
    unsigned char* ws = a.ws;
    { float* z = (float*)(ws + WS_SS); const int gt = gw * 64 + lane, GT = NGW * 64;
      for (int i = MTOK + gt; i < 7 * MTOK + 64 * 64 + 3456 + 64; i += GT) z[i] = 0.f; }
    { f32x2* rt = (f32x2*)(ws + WS_ROPE); const int gt = gw * 64 + lane, GT = NGW * 64;
      for (int i = gt; i < SEQ * 16; i += GT) { const int pos = i >> 4, j = i & 15;
          const float inv = exp2f(-(float)j * (13.287712379549449f / 16.0f));
          const float ang = (float)pos * inv;
          const double turns = (double)ang * 0.15915494309189535; const float fr = (float)(turns - floor(turns));
          rt[i] = (f32x2){__builtin_amdgcn_cosf(fr), __builtin_amdgcn_sinf(fr)}; } }
    LAS float* scr = (LAS float*)(lds + wave * 16384);
    { int base = 0;
      for (int mi = 0; mi < 12; ++mi) { const int ni = witems(mi); const WDesc d = wdesc(a, mi);
          int first = gw - (base % NGW); if (first < 0) first += NGW;
          for (int it = first; it < ni; it += NGW) transpose_item(d, scr, it, lane);
          base += ni; } }
    { float* ss0 = (float*)(ws + WS_SS); bf16* xb = (bf16*)(ws + WS_XB);
      for (int m0 = gw * 4; m0 < MTOK; m0 += NGW * 4) {
          f32x4 v[4][4];
#pragma unroll
          for (int r = 0; r < 4; ++r) { const f32x4* xr = (const f32x4*)(a.x + (size_t)(m0 + r) * DM) + lane;
#pragma unroll
              for (int j = 0; j < 4; ++j) v[r][j] = __builtin_nontemporal_load(xr + 64 * j); }
#pragma unroll
          for (int r = 0; r < 4; ++r) { unsigned long long* o8 = (unsigned long long*)(xb + (size_t)(m0 + r) * DM) + lane; float s = 0.f;
#pragma unroll
              for (int j = 0; j < 4; ++j) { const f32x4 w = v[r][j]; s += (w.x * w.x + w.y * w.y) + (w.z * w.z + w.w * w.w); o8[64 * j] = (unsigned long long)pk2f(w.x, w.y) | ((unsigned long long)pk2f(w.z, w.w) << 32); }
              s = wave_sum(s); if (lane == 0) ss0[m0 + r] = s; } } }
}

__device__ __forceinline__ void act_phase(bf16* gu, const float* cw, const float* cb, int gtid, int GT) {
    constexpr int NCH = FF / 8, RB = 32;
    for (int it = gtid; it < (MTOK / RB) * NCH; it += GT) {
        const int ch = it % NCH, rb = it / NCH, r0 = rb * RB, c = ch * 8;
        float w0[8], w1[8], w2[8], bb[8];
#pragma unroll
        for (int e = 0; e < 8; ++e) { w0[e] = cw[c + e]; w1[e] = cw[FF + c + e]; w2[e] = cw[2 * FF + c + e]; bb[e] = cb[c + e]; }
        float g2[8], g1[8];
        if ((r0 & (SEQ - 1)) == 0) {
#pragma unroll
            for (int e = 0; e < 8; ++e) { g2[e] = 0.f; g1[e] = 0.f; }
        } else {
            const v4u a2 = *(const v4u*)(gu + (size_t)(r0 - 2) * FF2 + c), a1 = *(const v4u*)(gu + (size_t)(r0 - 1) * FF2 + c);
            g2[0] = bf_lo(a2.x); g2[1] = bf_hi(a2.x); g2[2] = bf_lo(a2.y); g2[3] = bf_hi(a2.y); g2[4] = bf_lo(a2.z); g2[5] = bf_hi(a2.z); g2[6] = bf_lo(a2.w); g2[7] = bf_hi(a2.w);
            g1[0] = bf_lo(a1.x); g1[1] = bf_hi(a1.x); g1[2] = bf_lo(a1.y); g1[3] = bf_hi(a1.y); g1[4] = bf_lo(a1.z); g1[5] = bf_hi(a1.z); g1[6] = bf_lo(a1.w); g1[7] = bf_hi(a1.w);
        }
#pragma unroll 4
        for (int r = 0; r < RB; ++r) {
            bf16* gp = gu + (size_t)(r0 + r) * FF2 + c;
            const v4u ag = *(const v4u*)gp, au = *(const v4u*)(gp + FF);
            float g0[8], uu[8], y[8];
            g0[0] = bf_lo(ag.x); g0[1] = bf_hi(ag.x); g0[2] = bf_lo(ag.y); g0[3] = bf_hi(ag.y); g0[4] = bf_lo(ag.z); g0[5] = bf_hi(ag.z); g0[6] = bf_lo(ag.w); g0[7] = bf_hi(ag.w);
            uu[0] = bf_lo(au.x); uu[1] = bf_hi(au.x); uu[2] = bf_lo(au.y); uu[3] = bf_hi(au.y); uu[4] = bf_lo(au.z); uu[5] = bf_hi(au.z); uu[6] = bf_lo(au.w); uu[7] = bf_hi(au.w);
#pragma unroll
            for (int e = 0; e < 8; ++e) { const float xg = w0[e] * g2[e] + w1[e] * g1[e] + w2[e] * g0[e] + bb[e]; y[e] = xg * __builtin_amdgcn_rcpf(1.0f + __expf(-xg)) * uu[e]; g2[e] = g1[e]; g1[e] = g0[e]; }
            v4u o; o.x = pk2f(y[0], y[1]); o.y = pk2f(y[2], y[3]); o.z = pk2f(y[4], y[5]); o.w = pk2f(y[6], y[7]);
            *(v4u*)(gp + FF) = o;
        }
    }
}

__device__ __forceinline__ void ffn_fixup(const float* gf, const float* uf, const float* gl, const float* cw, const float* cb, bf16* Y, int gtid, int GT) {
    constexpr int NC4 = FF / 4, NG = MTOK / 64;
    for (int it = gtid; it < NG * 2 * NC4; it += GT) {
        const int c = (it % NC4) * 4, j = (it / NC4) & 1, g = it / (2 * NC4);
        const bool seq0 = (g & (SEQ / 64 - 1)) == 0;
        const f32x4 z = {0.f, 0.f, 0.f, 0.f};
        const f32x4 g0 = *(const f32x4*)(gf + (size_t)(g * 2 + j) * FF + c), u0 = *(const f32x4*)(uf + (size_t)(g * 2 + j) * FF + c);
        const f32x4 l0 = seq0 ? z : *(const f32x4*)(gl + (size_t)((g - 1) * 2 + 0) * FF + c), l1 = seq0 ? z : *(const f32x4*)(gl + (size_t)((g - 1) * 2 + 1) * FF + c);
        const f32x4 g1 = j ? *(const f32x4*)(gf + (size_t)(g * 2) * FF + c) : l1, g2 = j ? l1 : l0;
        const f32x4 w0 = *(const f32x4*)(cw + c), w1 = *(const f32x4*)(cw + FF + c), w2 = *(const f32x4*)(cw + 2 * FF + c), bb = *(const f32x4*)(cb + c);
        const f32x4 xg = w0 * g2 + w1 * g1 + w2 * g0 + bb; float y[4];
#pragma unroll
        for (int e = 0; e < 4; ++e) y[e] = xg[e] * __builtin_amdgcn_rcpf(1.0f + __expf(-xg[e])) * u0[e];
        unsigned long long o = (unsigned long long)pk2f(y[0], y[1]) | ((unsigned long long)pk2f(y[2], y[3]) << 32);
        *(unsigned long long*)(Y + (size_t)(g * 64 + j) * FF + c) = o;
    }
}

__device__ __forceinline__ void cumf_block(const float* lf, float* cumf, int bh, LAS float* scr, int tid) {
    const int b = bh >> 3, h = bh & 7, t0 = tid * 16, lane = tid & 63, wave = tid >> 6;
    float v[16]; float s = 0.f;
#pragma unroll
    for (int i = 0; i < 16; ++i) { s += lf[((size_t)b * SEQ + t0 + i) * 8 + h]; v[i] = s; }
    float incl = s;
#pragma unroll
    for (int o = 1; o < 64; o <<= 1) { const float up = __shfl_up(incl, o); if (lane >= o) incl += up; }
    if (lane == 63) scr[wave] = incl;
    __syncthreads();
    float woff = 0.f;
    for (int w = 0; w < wave; ++w) woff += scr[w];
    const float off = woff + incl - s;
    float* o = cumf + (size_t)bh * SEQ + t0;
#pragma unroll
    for (int i = 0; i < 16; ++i) o[i] = off + v[i];
    __syncthreads();
}

__device__ __forceinline__ void kmax_block(const bf16* kd  , unsigned* kmax_bits, int blk, int tid) {
    const int bh = blk >> 3, seg = blk & 7, b = bh >> 3, h = bh & 7, lj = tid & 7, kl = tid >> 3;
    const bf16* p = kd + ((size_t)b * SEQ + seg * 1024 + kl) * CD_PAD + h * 64 + lj * 8;
    v4u w[16];
#pragma unroll
    for (int i = 0; i < 16; ++i) w[i] = *(const v4u*)(p + (size_t)i * 64 * CD_PAD);
    float mx = 0.f;
#pragma unroll
    for (int i = 0; i < 16; ++i) { float s = 0.f;
#pragma unroll
        for (int e = 0; e < 4; ++e) { const float lo = bf_lo(w[i][e]), hi = bf_hi(w[i][e]); s += lo * lo + hi * hi; }
        s += __shfl_xor(s, 1); s += __shfl_xor(s, 2); s += __shfl_xor(s, 4); mx = fmaxf(mx, s); }
#pragma unroll
    for (int o = 8; o < 64; o <<= 1) mx = fmaxf(mx, __shfl_xor(mx, o));
    if ((tid & 63) == 0) atomicMax(kmax_bits + bh, __float_as_uint(sqrtf(mx)));
}

template <int LAYER>
__device__ __forceinline__ void attn_phase(const att::Ptrs& P0, const att::Ptrs& P1, unsigned* ctr, LAS unsigned char* lds) {
    const int x0 = blockIdx.x & 7;
    volatile LAS int* qidx = (volatile LAS int*)(lds + att::QIDX_OFF);
#pragma unroll 1
    for (int q = 0; q < 8; ++q) {
        const int x = (x0 + q) & 7; unsigned* my = ctr + x * 64;
        for (;;) {
            if (threadIdx.x == 0) *qidx = (int)atomicAdd(my, 1u);
            __syncthreads();
            const int i = *qidx;
            __syncthreads();
            if (i >= 256) break;
            if (LAYER == 0) {
                if (i < 128) att::attn_unit<1>(P1, i & 3, x, 31 - (i >> 2), lds);
                else { const int j = i - 128; att::attn_unit<0>(P0, j >> 5, x, 31 - (j & 31), lds); }
            } else {
                const int j = i & 127, qb = 31 - (j >> 2), b = j & 3;
                if (i >= 128) att::attn_unit<3>(P1, b, x, qb, lds);
                else att::attn_unit_sm<2>(P0, b, x, qb, lds);
            }
        }
    }
}

typedef __attribute__((address_space(1))) unsigned gu32;
#define XB_TMO      128
#define XB_XCNT(j)  (256  + 64 * (j))
#define XB_XSUB(j)  (1280 + 64 * (j))
#define XB_XGEN(j)  (2304 + 64 * (j))
#define XB_TOP      3328
#define XB_TOPGEN   3392
#define XCD_BAR_WORDS 3456
#define XB_SPIN_CAP (1u << 18)

__device__ __forceinline__ unsigned xb_ld(unsigned* p)              { return __hip_atomic_load(p, __ATOMIC_RELAXED, __HIP_MEMORY_SCOPE_AGENT); }
__device__ __forceinline__ unsigned xb_add(unsigned* p, unsigned v) { return __hip_atomic_fetch_add(p, v, __ATOMIC_RELAXED, __HIP_MEMORY_SCOPE_AGENT); }
__device__ __forceinline__ unsigned xb_xcc_id() { return (unsigned)__builtin_amdgcn_s_getreg((3 << 11) | 20) & 0xFu; }
#define XB_SPIN(cond, bar) do { unsigned _sp = 0; while (cond) { __builtin_amdgcn_s_sleep(1); \
    if ((++_sp & 255u) == 0u) { if (xb_ld(&(bar)[XB_TMO])) break; if (_sp > XB_SPIN_CAP) { atomicAdd(&(bar)[XB_TMO], 1u); break; } } } } while (0)

struct XcdBarrier {
    unsigned* bar; unsigned x;
    volatile LAS unsigned* st;
};

__device__ __forceinline__ XcdBarrier xcd_barrier_post(unsigned* bar, volatile LAS unsigned* st) {
    XcdBarrier b; b.bar = bar; b.x = xb_xcc_id(); b.st = st;
    if (threadIdx.x == 0) (void)xb_add(&bar[XB_XCNT(b.x)], 1u);
    return b;
}
__device__ __forceinline__ void xcd_barrier_complete(unsigned* bar, unsigned x, unsigned& nloc, unsigned& nx) {
    const unsigned G = gridDim.x * gridDim.y * gridDim.z;
    unsigned sum, cnt, mine, sp = 0u;
    for (;;) {
        sum = 0u; cnt = 0u; mine = 0u;
#pragma unroll
        for (unsigned j = 0; j < 16; ++j) { const unsigned c = xb_ld(&bar[XB_XCNT(j)]); sum += c; cnt += (c > 0u) ? 1u : 0u; mine = (j == x) ? c : mine; }
        if (sum == G) break;
        __builtin_amdgcn_s_sleep(1);
        if ((++sp & 255u) == 0u) { if (xb_ld(&bar[XB_TMO])) break; if (sp > XB_SPIN_CAP) { atomicAdd(&bar[XB_TMO], 1u); break; } }
    }
    nloc = mine > 0u ? mine : 1u; nx = cnt > 0u ? cnt : 1u;
}

__device__ __forceinline__ void xcd_barrier(const XcdBarrier& b) {
    asm volatile("s_waitcnt vmcnt(0)" ::: "memory");
    __syncthreads();
    if (threadIdx.x == 0) {
        unsigned* bar = b.bar;
        __builtin_amdgcn_s_waitcnt(0);
        unsigned nloc = b.st[0], nx = b.st[1];
        if (nloc == 0u) { xcd_barrier_complete(bar, b.x, nloc, nx); b.st[0] = nloc; b.st[1] = nx; }
        const unsigned old = xb_add(&bar[XB_XSUB(b.x)], 1u);
        const unsigned gen = old / nloc;
        if (old + 1u == (gen + 1u) * nloc) {
            __builtin_amdgcn_fence(__ATOMIC_RELEASE, "agent");
            asm volatile("s_waitcnt vmcnt(0)" ::: "memory");
            const unsigned og = xb_add(&bar[XB_TOP], 1u);
            const unsigned tg = og / nx;
            if (og + 1u == (tg + 1u) * nx) xb_add(&bar[XB_TOPGEN], 1u);
            else XB_SPIN(xb_ld(&bar[XB_TOPGEN]) == tg, bar);
            __builtin_amdgcn_fence(__ATOMIC_ACQUIRE, "agent");
            xb_add(&bar[XB_XGEN(b.x)], 1u);
            asm volatile("s_waitcnt vmcnt(0)" ::: "memory");
        } else {
            XB_SPIN(xb_ld(&bar[XB_XGEN(b.x)]) == gen, bar);
            __builtin_amdgcn_fence(__ATOMIC_ACQUIRE, "agent");
            asm volatile("s_waitcnt vmcnt(0)" ::: "memory");
        }
    }
    __syncthreads();
}

__device__ __forceinline__ int fresh_tid() { int t = threadIdx.x; asm volatile("" : "+v"(t)); return t; }
__global__ void __launch_bounds__(NTHR, 2) mk_fwd(Args a) {
    extern __shared__ __attribute__((aligned(16))) unsigned char lds_raw[];
    LAS unsigned char* lds = (LAS unsigned char*)lds_raw;
    cg::grid_group grid = cg::this_grid();
    const int G = gridDim.x, bx = blockIdx.x;
    const int NGW = G * NWAVES, GT = G * NTHR;
    unsigned char* ws = a.ws;
    float* SS = (float*)(ws + WS_SS);
    float *ss0 = SS, *ss1 = SS + MTOK, *ss2 = SS + 2 * MTOK, *ss3 = SS + 3 * MTOK, *ss4 = SS + 4 * MTOK, *ssq = SS + 5 * MTOK, *sskv = SS + 6 * MTOK;
    unsigned* qctr = (unsigned*)(ws + WS_QCTR);
    const f32x2* rope = (const f32x2*)(ws + WS_ROPE);
    float* lf = (float*)(ws + WS_LF); float* cumf = (float*)(ws + WS_CUMF); const float* kmaxp = (const float*)(ws + WS_KMAX);
    bf16* XB = (bf16*)(ws + WS_XB);
    bf16* BIG = (bf16*)(ws + WS_BIG);
    bf16* QKV = BIG; bf16* O0 = (bf16*)(ws + WS_BIG + 192 * MiB);
    bf16* PROJ = BIG; bf16* QC = (bf16*)(ws + WS_BIG + 144 * MiB); bf16* KVC = (bf16*)(ws + WS_BIG + 192 * MiB); bf16* O1 = (bf16*)(ws + WS_BIG + 256 * MiB);
    bf16* YB = BIG;
    float* stash_gf = (float*)(ws + WS_BIG + 192 * MiB); float* stash_uf = stash_gf + (size_t)(MTOK / 64) * 2 * FF; float* stash_gl = stash_uf + (size_t)(MTOK / 64) * 2 * FF;
    using pg8::Gemm; using pg8::StaticOrder;

    { volatile LAS unsigned* misc0 = (volatile LAS unsigned*)(lds + RING_BYTES + 320); if (threadIdx.x < 32) misc0[threadIdx.x] = 0u; }
    __syncthreads();
    { const int tid = fresh_tid(), lane = tid & 63, wave = __builtin_amdgcn_readfirstlane(tid >> 6); p0_prologue(a, lds, bx * NWAVES + wave, NGW, lane, wave); }
    grid.sync();
    (void)xcd_barrier_post((unsigned*)(ws + WS_BAR), (volatile LAS unsigned*)(lds + RING_BYTES + 320) + 8);
#define XBAR() do { XcdBarrier xb_; xb_.bar = (unsigned*)(a.ws + WS_BAR); xb_.x = xb_xcc_id(); xb_.st = (volatile LAS unsigned*)(lds + RING_BYTES + 320) + 8; xcd_barrier(xb_); } while (0)


#ifndef SKIP_P1
    { Gemm g{XB, (const bf16*)(ws + WS_W_AB), MTOK, AB_COLS, DM, DM}; StaticOrder S; S.init(MTOK, AB_COLS, G, bx);
      pg8::EpiScaleBf16 E{QKV, AB_COLS, ss0, 1.0f / DM};
      pg8::gemm_phase<pg8::EpiScaleBf16, StaticOrder, true, true>(lds, g, S, E); }
#endif
    XBAR();

#ifndef SKIP_ATT0
    { att::Ptrs PA{QKV, AB_COLS, 64, QKV + 512, AB_COLS, 64, nullptr, 0, QKV + 1024, AB_COLS, 64, O0, 0, a.ab_rel_bias, nullptr};
      att::Ptrs PB{QKV + 1536, AB_COLS, 64, QKV + 2048, AB_COLS, 64, nullptr, 0, QKV + 2560, AB_COLS, 64, O0, 512, nullptr, nullptr};
      attn_phase<0>(PA, PB, qctr, lds); }
#endif
    XBAR();

#ifndef SKIP_P3
    { Gemm g{O0, (const bf16*)(ws + WS_W_OAB), MTOK, DM, DM, DM}; StaticOrder S; S.init(MTOK, DM, G, bx);
      pg8::EpiResid E{a.x, nullptr, nullptr, XB, ss1};
      pg8::gemm_phase<pg8::EpiResid, StaticOrder, true, true>(lds, g, S, E); }
#endif
    XBAR();
#pragma unroll 1
    for (int layer = 0; layer < 2; ++layer) {

#ifndef SKIP_GU
        { Gemm g{XB, (const bf16*)(ws + (layer ? WS_W_GU1 : WS_W_GU0)), MTOK, FF2, DM, DM}; StaticOrder S; S.init(MTOK, FF2, G, bx);
          pg8::EpiGU E{YB, layer ? ss3 : ss1, a.ffn_conv_w + (size_t)layer * 3 * FF, a.ffn_conv_b + (size_t)layer * FF, stash_gf, stash_uf, stash_gl};
          pg8::gemm_phase<pg8::EpiGU, StaticOrder, true, true>(lds, g, S, E); }
#endif
        XBAR();

#ifndef SKIP_ACT
        ffn_fixup(stash_gf, stash_uf, stash_gl, a.ffn_conv_w + (size_t)layer * 3 * FF, a.ffn_conv_b + (size_t)layer * FF, YB, bx * NTHR + fresh_tid(), GT);
#endif
        XBAR();

#ifndef SKIP_DN
        { Gemm g{YB, (const bf16*)(ws + (layer ? WS_W_DN1 : WS_W_DN0)), MTOK, DM, FF, FF}; StaticOrder S; S.init(MTOK, DM, G, bx);
          pg8::EpiResid E{nullptr, XB, nullptr, XB, layer ? ss4 : ss2};
          pg8::gemm_phase<pg8::EpiResid, StaticOrder, true, true>(lds, g, S, E); }
#endif
        XBAR();
        if (layer == 0) {

#ifndef SKIP_CD
            { Gemm g{XB, (const bf16*)(ws + WS_W_CD), MTOK, CD_PAD, DM, DM}; StaticOrder S; S.init(MTOK, CD_PAD, G, bx);
              pg8::EpiCD E{PROJ, ss2, ssq, sskv, lf, a.cd_b_f, (const pg8::f32x2*)rope};
              pg8::gemm_phase<pg8::EpiCD, StaticOrder, true, true>(lds, g, S, E); }
#endif
            XBAR();

#ifndef SKIP_P8
#ifndef SKIP_CUMF
            kmax_block(PROJ + 1184, (unsigned*)(ws + WS_KMAX), bx, fresh_tid());
            if (bx < 32) cumf_block(lf, cumf, bx, (LAS float*)lds, fresh_tid());
#endif
#ifndef SKIP_QUP
            { Gemm g{PROJ, (const bf16*)(ws + WS_W_UQ), MTOK, QC_COLS, Q_RANK, CD_PAD}; StaticOrder S; S.init(MTOK, QC_COLS, G, bx);
              pg8::EpiQ E{QC, ssq, (const pg8::f32x2*)rope};
              pg8::gemm_phase<pg8::EpiQ, StaticOrder, true, true>(lds, g, S, E); }
#endif
#ifndef SKIP_KVUP
            { Gemm g{PROJ + Q_RANK, (const bf16*)(ws + WS_W_UKV), MTOK, KVC_COLS, KV_RANK, CD_PAD}; StaticOrder S; S.init(MTOK, KVC_COLS, G, bx);
              pg8::EpiScaleBf16 E{KVC, KVC_COLS, sskv, 1.0f / KV_RANK};
              pg8::gemm_phase<pg8::EpiScaleBf16, StaticOrder, true, true>(lds, g, S, E); }
#endif
#endif
            XBAR();

#ifndef SKIP_ATT1
            { att::Ptrs PC{QC, QC_COLS, 96, KVC, KVC_COLS, 128, PROJ + 640, CD_PAD, KVC + 64, KVC_COLS, 128, O1, 0, nullptr, nullptr};
              att::Ptrs PD{PROJ + 672, CD_PAD, 64, PROJ + 1184, CD_PAD, 64, nullptr, 0, PROJ + 1696, CD_PAD, 64, O1, 512, cumf, kmaxp};
              attn_phase<1>(PC, PD, qctr + 8 * 64, lds); }
#endif
            XBAR();

#ifndef SKIP_P10
            { Gemm g{O1, (const bf16*)(ws + WS_W_OCD), MTOK, DM, DM, DM}; StaticOrder S; S.init(MTOK, DM, G, bx);
              pg8::EpiResid E{nullptr, XB, nullptr, XB, ss3};
              pg8::gemm_phase<pg8::EpiResid, StaticOrder, true, true>(lds, g, S, E); }
#endif
            XBAR();
        }
    }
    const int tidf = fresh_tid(), lane = tidf & 63, gw = bx * NWAVES + __builtin_amdgcn_readfirstlane(tidf >> 6);
    { const f32x4* gr = (const f32x4*)a.final_norm + lane; f32x4 gg[4];
#pragma unroll
      for (int j = 0; j < 4; ++j) gg[j] = gr[64 * j];
      for (int m0 = gw * 4; m0 < MTOK; m0 += NGW * 4) { unsigned long long v[4][4]; float rs[4];
#pragma unroll
          for (int r = 0; r < 4; ++r) { const unsigned long long* xr = (const unsigned long long*)(XB + (size_t)(m0 + r) * DM) + lane; rs[r] = rsqrtf(ss4[m0 + r] * (1.0f / DM) + RMS_EPS);
#pragma unroll
              for (int j = 0; j < 4; ++j) v[r][j] = xr[64 * j]; }
#pragma unroll
          for (int r = 0; r < 4; ++r) { f32x4* xw = (f32x4*)(a.out + (size_t)(m0 + r) * DM) + lane;
#pragma unroll
              for (int j = 0; j < 4; ++j) { const unsigned lo = (unsigned)v[r][j], hi = (unsigned)(v[r][j] >> 32); const f32x4 x4 = {bf_lo(lo), bf_hi(lo), bf_lo(hi), bf_hi(hi)};
                  __builtin_nontemporal_store(x4 * rs[r] * gg[j], xw + 64 * j); } } } }
}

extern "C" void kernel_launch(void* const* d_in, const int* in_sizes, int n_in, void* d_out, int out_size, void* d_ws, size_t ws_size, hipStream_t stream) {
    static int grid = 0;
    if (grid == 0) {
        if (n_in != 20 || in_sizes[0] != MTOK * DM || out_size != MTOK * DM || ws_size < WS_END) { fprintf(stderr, "kernel_launch: unexpected shapes / workspace (n_in %d, in0 %d, out %d, ws %zu, need %zu)\n", n_in, n_in > 0 ? in_sizes[0] : -1, out_size, ws_size, (size_t)WS_END); grid = -1; return; }
        int dev = 0, cus = 0, per_cu = 0;
        if (hipGetDevice(&dev) != hipSuccess || hipDeviceGetAttribute(&cus, hipDeviceAttributeMultiprocessorCount, dev) != hipSuccess) { grid = -1; return; }
        if (hipFuncSetAttribute((const void*)mk_fwd, hipFuncAttributeMaxDynamicSharedMemorySize, LDS_BYTES) != hipSuccess) { fprintf(stderr, "kernel_launch: hipFuncSetAttribute failed\n"); grid = -1; return; }
        if (hipOccupancyMaxActiveBlocksPerMultiprocessor(&per_cu, (const void*)mk_fwd, NTHR, LDS_BYTES) != hipSuccess || per_cu < 1) { fprintf(stderr, "kernel_launch: occupancy query says %d blocks per CU\n", per_cu); }
        (void)hipGetLastError();
        grid = cus;
    }
    if (grid < 0) return;
    Args a{};
    const float** p = (const float**)&a;
    for (int i = 0; i < 20; ++i) p[i] = (const float*)d_in[i];
    a.out = (float*)d_out; a.ws = (unsigned char*)d_ws;
    void* args[] = {&a};
    hipError_t e = hipLaunchCooperativeKernel((const void*)mk_fwd, dim3(grid), dim3(NTHR), args, LDS_BYTES, stream);
    if (e != hipSuccess) fprintf(stderr, "cooperative launch failed: %s (grid %d)\n", hipGetErrorString(e), grid);
}
```

```cpp
#include <hip/hip_runtime.h>
#include <hip/hip_cooperative_groups.h>
#include <cstdio>
#include <cstdint>
namespace cg = cooperative_groups;

constexpr int BATCH = 4, SEQ = 8192, DM = 1024, MTOK = BATCH * SEQ;
constexpr int AB_COLS = 3072, CD_COLS = 2216, CD_PAD = 2304, FF = 2816, FF2 = 2 * FF;
constexpr int Q_RANK = 384, KV_RANK = 256, QC_COLS = 768, KVC_COLS = 1024;
constexpr float RMS_EPS = 1e-6f, LOG2E = 1.4426950408889634f;
namespace pg8 {
#define PG8_LAS __attribute__((address_space(3)))
typedef unsigned short bf16_t;
typedef short bf16x8 __attribute__((ext_vector_type(8)));
typedef float f32x4 __attribute__((ext_vector_type(4)));
typedef unsigned u32x4 __attribute__((ext_vector_type(4)));
constexpr int BM = 256, BK = 64, HALF = 128, HTB = HALF * BK * 2  , STAGE_BYTES = 8 * HTB, NXCD = 8, WGM = 4;

__host__ __device__ __forceinline__ int lds_byte(int r, int c) { const int st = (r >> 4) * 2 + (c >> 5), rr = r & 15, cc = c & 31, ob = rr * 64 + cc * 2; return st * 1024 + (ob ^ (((ob >> 9) & 1) << 5)); }
__host__ __device__ __forceinline__ void stage_rc(int b, int& R, int& C) { const int st = b / 1024, sb = b % 1024, swz = sb ^ (((sb >> 9) & 1) << 5); R = (st >> 1) * 16 + swz / 64; C = (st & 1) * 32 + (swz % 64) / 2; }
__host__ __device__ __forceinline__ int perm32(int rho) { const int n = rho >> 4, i = rho & 15; return 8 * (i >> 2) + 4 * n + (i & 3); }

struct Unit { int pm, pn; };
struct Gemm { const bf16_t* A; const bf16_t* Bt; int M, N, K, lda; };

struct StaticOrder {
    int nM, nN, nwg, G, c;
    __host__ __device__ void init(int M, int N, int G_, int c_) { nM = M / BM; nN = N / BM; nwg = nM * nN; G = G_; c = c_; }
    __host__ __device__ bool next(int i, Unit& u) const {
        const long L = (long)i * G + c; if (L >= nwg) return false;
        int wgid = (int)L; { const int q = nwg / NXCD, r = nwg % NXCD, xcd = wgid % NXCD, off = wgid / NXCD; wgid = (xcd < r ? xcd * (q + 1) : r * (q + 1) + (xcd - r) * q) + off; }
        const int nig = WGM * nN, gid = wgid / nig, fm = gid * WGM, gsz = (nM - fm) < WGM ? (nM - fm) : WGM;
        u.pm = fm + ((wgid % nig) % gsz); u.pn = (wgid % nig) / gsz; return true;
    }
    __device__ __forceinline__ void a_ready(const Unit&) const {}
    __device__ __forceinline__ void done(const Unit&) const {}
};

__device__ __forceinline__ unsigned cvt_pk_bf16(float lo, float hi) { unsigned r; asm volatile("v_cvt_pk_bf16_f32 %0, %1, %2" : "=v"(r) : "v"(lo), "v"(hi)); return r; }
typedef unsigned u32x2 __attribute__((ext_vector_type(2)));
typedef float f32x2 __attribute__((ext_vector_type(2)));

struct EpiScaleBf16 {
    static constexpr bool PERM = true, AFTER_DRAIN = false;
    bf16_t* O; int ldc; const float* ss; float inv_n;
    __device__ __forceinline__ void operator()(const f32x4 (&acc)[2][2][4][2], const Unit& u, int wr, int wc, int fr, int fq) const {
        const int row0 = u.pm * BM + wr * 64 + fr; const int col0 = u.pn * BM + wc * 32 + 8 * fq;
#pragma unroll
        for (int ai = 0; ai < 2; ++ai)
#pragma unroll
            for (int m = 0; m < 4; ++m) { const int row = row0 + ai * HALF + m * 16; const float rs = rsqrtf(ss[row] * inv_n + RMS_EPS); bf16_t* rowp = O + (size_t)row * ldc + col0;
#pragma unroll
                for (int bj = 0; bj < 2; ++bj) { const f32x4 v0 = acc[ai][bj][m][0] * rs, v1 = acc[ai][bj][m][1] * rs;
                    u32x4 w; w.x = cvt_pk_bf16(v0[0], v0[1]); w.y = cvt_pk_bf16(v0[2], v0[3]); w.z = cvt_pk_bf16(v1[0], v1[1]); w.w = cvt_pk_bf16(v1[2], v1[3]);
                    *(u32x4*)(rowp + bj * HALF) = w; } }
    }
};

struct EpiResid {
    static constexpr bool PERM = false, AFTER_DRAIN = false;
    const float* base32; const bf16_t* base16; float* out; bf16_t* xb; float* ss;
    __device__ __forceinline__ void operator()(const f32x4 (&acc)[2][2][4][2], const Unit& u, int wr, int wc, int fr, int fq) const {
        const int col0 = u.pn * BM + wc * 32 + 4 * fq;
#pragma unroll
        for (int ai = 0; ai < 2; ++ai)
#pragma unroll
            for (int m = 0; m < 4; ++m) { const int row = u.pm * BM + ai * HALF + wr * 64 + m * 16 + fr; const size_t off = (size_t)row * DM + col0; float s = 0.f;
#pragma unroll
                for (int bj = 0; bj < 2; ++bj)
#pragma unroll
                    for (int n = 0; n < 2; ++n) { const size_t o2 = off + bj * HALF + n * 16; f32x4 bv;
                        if (base32) bv = *(const f32x4*)(base32 + o2);
                        else { const u32x2 bw = *(const u32x2*)(base16 + o2); bv[0] = __uint_as_float(bw.x << 16); bv[1] = __uint_as_float(bw.x & 0xffff0000u); bv[2] = __uint_as_float(bw.y << 16); bv[3] = __uint_as_float(bw.y & 0xffff0000u); }
                        const f32x4 v = bv + acc[ai][bj][m][n];
                        if (out) *(f32x4*)(out + o2) = v;
                        s += (v[0] * v[0] + v[1] * v[1]) + (v[2] * v[2] + v[3] * v[3]);
                        { u32x2 w; w.x = cvt_pk_bf16(v[0], v[1]); w.y = cvt_pk_bf16(v[2], v[3]); *(u32x2*)(xb + o2) = w; } }
                s += __shfl_xor(s, 16); s += __shfl_xor(s, 32);
                if (fq == 0) atomicAdd(ss + row, s);
                asm volatile("" ::: "memory"); }
    }
};

struct EpiCD {
    static constexpr bool PERM = false, AFTER_DRAIN = false;
    bf16_t* proj; const float* ss_in; float* ssq; float* sskv; float* lf; const float* b_f; const f32x2* rope;
    __device__ __forceinline__ void operator()(const f32x4 (&acc)[2][2][4][2], const Unit& u, int wr, int wc, int fr, int fq) const {
#pragma unroll
        for (int ai = 0; ai < 2; ++ai)
#pragma unroll
            for (int m = 0; m < 4; ++m) { const int row = u.pm * BM + ai * HALF + wr * 64 + m * 16 + fr; const float rs = rsqrtf(ss_in[row] * (1.0f / DM) + RMS_EPS); const int pos = row & (SEQ - 1);
#pragma unroll
                for (int bj = 0; bj < 2; ++bj) { const int cbase = u.pn * BM + bj * HALF + wc * 32;
                    f32x4 v0 = acc[ai][bj][m][0] * rs, v1 = acc[ai][bj][m][1] * rs;
                    if (cbase < Q_RANK + KV_RANK) {
                        float s = ((v0[0] * v0[0] + v0[1] * v0[1]) + (v0[2] * v0[2] + v0[3] * v0[3])) + ((v1[0] * v1[0] + v1[1] * v1[1]) + (v1[2] * v1[2] + v1[3] * v1[3]));
                        s += __shfl_xor(s, 16); s += __shfl_xor(s, 32);
                        if (fq == 0) atomicAdd((cbase < Q_RANK ? ssq : sskv) + row, s);
                    } else if (cbase == Q_RANK + KV_RANK) {
#pragma unroll
                        for (int e = 0; e < 4; ++e) { const f32x2 cs = rope[pos * 16 + 4 * fq + e]; const float x1 = v0[e], x2 = v1[e]; v0[e] = x1 * cs.x - x2 * cs.y; v1[e] = x2 * cs.x + x1 * cs.y; }
                    } else if (cbase == 2208) {
                        if (fq < 2) {
#pragma unroll
                            for (int e = 0; e < 4; ++e) { const int h = 4 * fq + e; const float z = v0[e] + b_f[h]; const float ls = -(fmaxf(-z, 0.f) + logf(1.0f + expf(-fabsf(z)))); lf[(size_t)row * 8 + h] = ls * LOG2E; }
                        }
                    }
                    if (cbase < 2208) { bf16_t* p = proj + (size_t)row * CD_PAD + cbase + 4 * fq;
                        u32x2 w0, w1; w0.x = cvt_pk_bf16(v0[0], v0[1]); w0.y = cvt_pk_bf16(v0[2], v0[3]); w1.x = cvt_pk_bf16(v1[0], v1[1]); w1.y = cvt_pk_bf16(v1[2], v1[3]);
                        *(u32x2*)p = w0; *(u32x2*)(p + 16) = w1; } }
                asm volatile("" ::: "memory"); }
    }
};

struct EpiQ {
    static constexpr bool PERM = false, AFTER_DRAIN = false;
    bf16_t* qc; const float* ssq; const f32x2* rope;
    __device__ __forceinline__ void operator()(const f32x4 (&acc)[2][2][4][2], const Unit& u, int wr, int wc, int fr, int fq) const {
#pragma unroll
        for (int ai = 0; ai < 2; ++ai)
#pragma unroll
            for (int m = 0; m < 4; ++m) { const int row = u.pm * BM + ai * HALF + wr * 64 + m * 16 + fr; const float rs = rsqrtf(ssq[row] * (1.0f / Q_RANK) + RMS_EPS); const int pos = row & (SEQ - 1);
#pragma unroll
                for (int bj = 0; bj < 2; ++bj) { const int cbase = u.pn * BM + bj * HALF + wc * 32;
                    f32x4 v0 = acc[ai][bj][m][0] * rs, v1 = acc[ai][bj][m][1] * rs;
                    if (((cbase >> 5) % 3) == 2) {
#pragma unroll
                        for (int e = 0; e < 4; ++e) { const f32x2 cs = rope[pos * 16 + 4 * fq + e]; const float x1 = v0[e], x2 = v1[e]; v0[e] = x1 * cs.x - x2 * cs.y; v1[e] = x2 * cs.x + x1 * cs.y; }
                    }
                    bf16_t* p = qc + (size_t)row * QC_COLS + cbase + 4 * fq;
                    u32x2 w0, w1; w0.x = cvt_pk_bf16(v0[0], v0[1]); w0.y = cvt_pk_bf16(v0[2], v0[3]); w1.x = cvt_pk_bf16(v1[0], v1[1]); w1.y = cvt_pk_bf16(v1[2], v1[3]);
                    *(u32x2*)p = w0; *(u32x2*)(p + 16) = w1; }
                asm volatile("" ::: "memory"); }
    }
};

template <int CTRL> __device__ __forceinline__ float dpp_row_ror(float v) { return __int_as_float(__builtin_amdgcn_update_dpp(0, __float_as_int(v), CTRL, 0xF, 0xF, false)); }
struct EpiGU {
    static constexpr bool PERM = false, AFTER_DRAIN = false;
    bf16_t* Y; const float* ss; const float* cw; const float* cb; float* gf; float* uf; float* gl;
    __device__ __forceinline__ void operator()(const f32x4 (&acc)[2][2][4][2], const Unit& u, int wr, int wc, int fr, int fq) const {
#pragma unroll
        for (int ai = 0; ai < 2; ++ai) {
            const int grp = u.pm * 4 + ai * 2 + wr, rowg = grp * 64;
            float rs[4];
#pragma unroll
            for (int m = 0; m < 4; ++m) rs[m] = rsqrtf(ss[rowg + 16 * m + fr] * (1.0f / DM) + RMS_EPS);
#pragma unroll
            for (int n = 0; n < 2; ++n) {
                const int c = u.pn * HALF + wc * 32 + n * 16 + 4 * fq;
                const f32x4 w0 = *(const f32x4*)(cw + c), w1 = *(const f32x4*)(cw + FF + c), w2 = *(const f32x4*)(cw + 2 * FF + c), bb = *(const f32x4*)(cb + c);
                f32x4 pr1 = {0.f, 0.f, 0.f, 0.f}, pr2 = {0.f, 0.f, 0.f, 0.f};
#pragma unroll
                for (int m = 0; m < 4; ++m) {
                    const f32x4 g0 = acc[ai][0][m][n] * rs[m], u0 = acc[ai][1][m][n] * rs[m];
                    f32x4 r1, r2;
#pragma unroll
                    for (int e2 = 0; e2 < 4; ++e2) { r1[e2] = dpp_row_ror<0x121>(g0[e2]); r2[e2] = dpp_row_ror<0x122>(g0[e2]); }
                    const f32x4 g1 = (fr >= 1) ? r1 : pr1, g2 = (fr >= 2) ? r2 : pr2;
                    pr1 = r1; pr2 = r2;
                    const f32x4 xg = w0 * g2 + w1 * g1 + w2 * g0 + bb; f32x4 y;
#pragma unroll
                    for (int e2 = 0; e2 < 4; ++e2) y[e2] = xg[e2] * __builtin_amdgcn_rcpf(1.0f + __expf(-xg[e2])) * u0[e2];
                    const int row = rowg + 16 * m + fr;
                    if (m > 0 || fr >= 2) { u32x2 w; w.x = cvt_pk_bf16(y[0], y[1]); w.y = cvt_pk_bf16(y[2], y[3]); *(u32x2*)(Y + (size_t)row * FF + c) = w; }
                    if (m == 0) { if (fr < 2) { *(f32x4*)(gf + (size_t)(grp * 2 + fr) * FF + c) = g0; *(f32x4*)(uf + (size_t)(grp * 2 + fr) * FF + c) = u0; } }
                    if (m == 3) { if (fr >= 14) *(f32x4*)(gl + (size_t)(grp * 2 + fr - 14) * FF + c) = g0; }
                }
            }
            asm volatile("" ::: "memory");
        }
    }
};

template <class Epi, class Sched, bool ALIGN_EPI = false, bool SP2 = false>
__device__ __forceinline__ void gemm_phase(PG8_LAS unsigned char* lds, const Gemm g, const Sched& S, const Epi& E) {
    int tid_ = threadIdx.x; asm volatile("" : "+v"(tid_)); const int tid = tid_, wid = __builtin_amdgcn_readfirstlane(tid >> 6), lane = tid & 63, wr = wid >> 2, wc = wid & 3, fr = lane & 15, fq = lane >> 4;
    int K_ = g.K; asm volatile("" : "+s"(K_)); const int K = K_, nt = K / BK;
    unsigned voffA[2], voffB[2];
#pragma unroll
    for (int i = 0; i < 2; ++i) { int R, C; stage_rc(tid * 16 + i * 8192, R, C); const int Rb = Epi::PERM ? ((R & ~31) + perm32(R & 31)) : R;
        voffA[i] = (unsigned)(R * g.lda + C) * 2u; voffB[i] = (unsigned)(Rb * K + C) * 2u; }
    const size_t kstep = (size_t)(BK * 2);
    const size_t hstepB = (size_t)HALF * K * 2, hstepA = (size_t)HALF * g.lda * 2;
    const size_t tstepA = 2 * hstepA, tstepB = 2 * hstepB;
    const unsigned ldsw = (unsigned)wid * 1024u;
    const int aoff = lds_byte(wr * 64 + fr, fq * 8), boff = lds_byte(wc * 32 + fr, fq * 8);
#define PG8_SA(b, h) (((b) * 2 + (h)) * HTB)
#define PG8_SB(b, h) ((4 + (b) * 2 + (h)) * HTB)
#define PG8_STAGE(bufoff, gbase, voff) do { _Pragma("unroll") for (int _i = 0; _i < 2; ++_i) \
        __builtin_amdgcn_global_load_lds((const unsigned*)((const char*)(gbase) + (voff)[_i]), (PG8_LAS unsigned*)(lds + (bufoff) + ldsw + _i * 8192), 16, 0, 0); } while (0)
#define PG8_LDA(dst, b, h) do { _Pragma("unroll") for (int m = 0; m < 4; ++m) _Pragma("unroll") for (int k = 0; k < 2; ++k) dst[m][k] = *(const PG8_LAS bf16x8*)(lds + PG8_SA(b, h) + aoff + m * 2048 + k * 1024); } while (0)
#define PG8_LDB(dst, b, h) do { _Pragma("unroll") for (int n = 0; n < 2; ++n) _Pragma("unroll") for (int k = 0; k < 2; ++k) dst[n][k] = *(const PG8_LAS bf16x8*)(lds + PG8_SB(b, h) + boff + n * 2048 + k * 1024); } while (0)
#define PG8_MMA(ai, bj, At, Bt) do { __builtin_amdgcn_s_setprio(1); _Pragma("unroll") for (int m = 0; m < 4; ++m) _Pragma("unroll") for (int n = 0; n < 2; ++n) _Pragma("unroll") for (int k = 0; k < 2; ++k) \
        acc[ai][bj][m][n] = __builtin_amdgcn_mfma_f32_16x16x32_bf16(Bt[n][k], At[m][k], acc[ai][bj][m][n], 0, 0, 0); __builtin_amdgcn_s_setprio(0); } while (0)
#define PG8_WAIT_V(n) asm volatile("s_waitcnt vmcnt(" #n ")" ::: "memory")
#define PG8_WAIT_L(n) asm volatile("s_waitcnt lgkmcnt(" #n ")" ::: "memory")
#define PG8_BAR __builtin_amdgcn_s_barrier()
#define PG8_SCHED __builtin_amdgcn_sched_barrier(0)
    Unit cur, nxt; int ui = 0;
    if (!S.next(0, cur)) return;
    f32x4 acc[2][2][4][2];
#pragma unroll
    for (int a = 0; a < 2; ++a)
#pragma unroll
        for (int b = 0; b < 2; ++b)
#pragma unroll
            for (int m = 0; m < 4; ++m)
#pragma unroll
                for (int n = 0; n < 2; ++n) acc[a][b][m][n] = (f32x4){0.f, 0.f, 0.f, 0.f};
    bf16x8 At[4][2], B0[2][2], B1[2][2];
    const char* cA = (const char*)g.A + (size_t)cur.pm * tstepA; const char* cB = (const char*)g.Bt + (size_t)cur.pn * tstepB;
    S.a_ready(cur);
    if constexpr (SP2) {
        PG8_STAGE(PG8_SB(0, 0), cB, voffB); PG8_STAGE(PG8_SB(0, 1), cB + hstepB, voffB); PG8_STAGE(PG8_SA(0, 0), cA, voffA); PG8_STAGE(PG8_SA(0, 1), cA + hstepA, voffA);
        if (wr == 1) PG8_BAR;
        PG8_WAIT_V(2); PG8_BAR;
        PG8_STAGE(PG8_SB(1, 0), cB + kstep, voffB); PG8_STAGE(PG8_SA(1, 0), cA + kstep, voffA); PG8_STAGE(PG8_SB(1, 1), cB + hstepB + kstep, voffB);
        PG8_WAIT_V(6); PG8_BAR;
    } else {
        PG8_STAGE(PG8_SB(0, 0), cB, voffB); PG8_STAGE(PG8_SA(0, 0), cA, voffA); PG8_STAGE(PG8_SB(0, 1), cB + hstepB, voffB); PG8_STAGE(PG8_SA(0, 1), cA + hstepA, voffA);
        if (wr == 1) PG8_BAR;
        PG8_WAIT_V(4); PG8_BAR;
        PG8_STAGE(PG8_SB(1, 0), cB + kstep, voffB); PG8_STAGE(PG8_SA(1, 0), cA + kstep, voffA); PG8_STAGE(PG8_SB(1, 1), cB + hstepB + kstep, voffB);
        PG8_WAIT_V(6); PG8_BAR;
    }
    for (;;) {
        const bool has_next = S.next(ui + 1, nxt);
        const char* nA = has_next ? (const char*)g.A + (size_t)nxt.pm * tstepA : cA; const char* nB = has_next ? (const char*)g.Bt + (size_t)nxt.pn * tstepB : cB;
        for (int t = 0; t < nt; t += 2) {
            const bool last = (t == nt - 2);
            const char* a1 = cA + (size_t)(t + 1) * kstep;
            const char* a2 = last ? nA : cA + (size_t)(t + 2) * kstep; const char* b2 = last ? nB : cB + (size_t)(t + 2) * kstep;
            const char* a3 = a2 + kstep; const char* b3 = b2 + kstep;
            if (last && has_next) S.a_ready(nxt);
            if constexpr (SP2) {
            PG8_LDB(B0, 0, 0); PG8_LDB(B1, 0, 1); PG8_SCHED; PG8_LDA(At, 0, 0); PG8_STAGE(PG8_SA(1, 1), a1 + hstepA, voffA);
            PG8_WAIT_V(8); PG8_WAIT_L(0); PG8_BAR; PG8_MMA(0, 0, At, B0); PG8_MMA(0, 1, At, B1); PG8_BAR; PG8_SCHED;
            PG8_LDA(At, 0, 1); PG8_STAGE(PG8_SB(0, 0), b2, voffB); PG8_STAGE(PG8_SB(0, 1), b2 + hstepB, voffB); PG8_STAGE(PG8_SA(0, 0), a2, voffA);
            PG8_WAIT_V(8); PG8_WAIT_L(0); PG8_BAR; PG8_MMA(1, 0, At, B0); PG8_MMA(1, 1, At, B1); PG8_BAR; PG8_SCHED;
            PG8_LDB(B0, 1, 0); PG8_LDB(B1, 1, 1); PG8_SCHED; PG8_LDA(At, 1, 0); PG8_STAGE(PG8_SA(0, 1), a2 + hstepA, voffA);
            PG8_WAIT_V(8); PG8_WAIT_L(0); PG8_BAR; PG8_MMA(0, 0, At, B0); PG8_MMA(0, 1, At, B1); PG8_BAR; PG8_SCHED;
            PG8_LDA(At, 1, 1); PG8_STAGE(PG8_SB(1, 0), b3, voffB); PG8_STAGE(PG8_SB(1, 1), b3 + hstepB, voffB); PG8_STAGE(PG8_SA(1, 0), a3, voffA);
            PG8_WAIT_V(8); PG8_WAIT_L(0); PG8_BAR; PG8_MMA(1, 0, At, B0); PG8_MMA(1, 1, At, B1); PG8_BAR; PG8_SCHED;
            } else {
            PG8_LDB(B0, 0, 0); PG8_SCHED; PG8_LDA(At, 0, 0); PG8_STAGE(PG8_SA(1, 1), a1 + hstepA, voffA);
            PG8_WAIT_L(8); PG8_BAR; PG8_WAIT_L(0); PG8_MMA(0, 0, At, B0); PG8_BAR; PG8_SCHED;
            PG8_LDB(B1, 0, 1); PG8_STAGE(PG8_SB(0, 0), b2, voffB);
            PG8_BAR; PG8_WAIT_L(0); PG8_MMA(0, 1, At, B1); PG8_BAR;
            PG8_LDA(At, 0, 1); PG8_STAGE(PG8_SA(0, 0), a2, voffA);
            PG8_BAR; PG8_WAIT_L(0); PG8_MMA(1, 0, At, B0); PG8_BAR; PG8_SCHED;
            PG8_STAGE(PG8_SB(0, 1), b2 + hstepB, voffB);
            PG8_WAIT_V(6); PG8_BAR; PG8_MMA(1, 1, At, B1); PG8_BAR;
            PG8_LDB(B0, 1, 0); PG8_SCHED; PG8_LDA(At, 1, 0); PG8_STAGE(PG8_SA(0, 1), a2 + hstepA, voffA);
            PG8_WAIT_L(8); PG8_BAR; PG8_WAIT_L(0); PG8_MMA(0, 0, At, B0); PG8_BAR; PG8_SCHED;
            PG8_LDB(B1, 1, 1); PG8_STAGE(PG8_SB(1, 0), b3, voffB);
            PG8_BAR; PG8_WAIT_L(0); PG8_MMA(0, 1, At, B1); PG8_BAR;
            PG8_LDA(At, 1, 1); PG8_STAGE(PG8_SA(1, 0), a3, voffA);
            PG8_BAR; PG8_WAIT_L(0); PG8_MMA(1, 0, At, B0); PG8_BAR; PG8_SCHED;
            PG8_STAGE(PG8_SB(1, 1), b3 + hstepB, voffB);
            PG8_WAIT_V(6); PG8_BAR; PG8_MMA(1, 1, At, B1); PG8_BAR;
            }
        }
        if constexpr (ALIGN_EPI) { if (wr == 0) PG8_BAR; }
        if constexpr (!Epi::AFTER_DRAIN) { E(acc, cur, wr, wc, fr, fq); S.done(cur); }
        if (!has_next) break;
#pragma unroll
        for (int a = 0; a < 2; ++a)
#pragma unroll
            for (int b = 0; b < 2; ++b)
#pragma unroll
                for (int m = 0; m < 4; ++m)
#pragma unroll
                    for (int n = 0; n < 2; ++n) acc[a][b][m][n] = (f32x4){0.f, 0.f, 0.f, 0.f};
        cur = nxt; cA = nA; cB = nB; ++ui;
        if constexpr (ALIGN_EPI) { if (wr == 1) PG8_BAR; }
    }
    PG8_WAIT_V(0);
    if constexpr (!ALIGN_EPI) { if (wr == 0) PG8_BAR; }
    PG8_BAR;
    if constexpr (Epi::AFTER_DRAIN) { E.fused(acc, cur, wr, wc, fr, fq, lds, wid, lane); S.done(cur); }
#undef PG8_SA
#undef PG8_SB
#undef PG8_STAGE
#undef PG8_LDA
#undef PG8_LDB
#undef PG8_MMA
#undef PG8_WAIT_V
#undef PG8_WAIT_L
#undef PG8_BAR
#undef PG8_SCHED
}
}
namespace att {
#define LAS3 __attribute__((address_space(3)))
typedef unsigned short bf16_t;
typedef short bf16x8 __attribute__((ext_vector_type(8)));
typedef short s16x4 __attribute__((ext_vector_type(4)));
typedef float f32x16 __attribute__((ext_vector_type(16)));
typedef float f32x4 __attribute__((ext_vector_type(4)));
typedef unsigned u32x4 __attribute__((ext_vector_type(4)));
typedef unsigned u32x2 __attribute__((ext_vector_type(2)));
constexpr int KBUF = 13312, VBUF = 8192, FBUF = 256, BUFB = KBUF + VBUF + FBUF;
constexpr int TB_OFF = 3 * BUFB, QIDX_OFF = TB_OFF + 1040, FLAG_OFF = QIDX_OFF + 16, ATT_LDS = FLAG_OFF + 16;
constexpr float NEG_BIG = -1.0e30f;

typedef float f32x2_t __attribute__((ext_vector_type(2))); typedef __bf16 bf16x2_t __attribute__((ext_vector_type(2)));
__device__ __forceinline__ unsigned pk2(float lo, float hi) { f32x2_t v = {lo, hi}; bf16x2_t b = __builtin_convertvector(v, bf16x2_t); return __builtin_bit_cast(unsigned, b); }
__device__ __forceinline__ float lane32_other(float v) {
    auto rr = __builtin_amdgcn_permlane32_swap(__float_as_uint(v), __float_as_uint(v), false, false);
    return (__lane_id() & 32) ? __uint_as_float(rr[0]) : __uint_as_float(rr[1]);
}
__device__ __forceinline__ float lane32_max(float v) { auto rr = __builtin_amdgcn_permlane32_swap(__float_as_uint(v), __float_as_uint(v), false, false); return fmaxf(__uint_as_float(rr[0]), __uint_as_float(rr[1])); }
__device__ __forceinline__ float lane32_sum(float v) { auto rr = __builtin_amdgcn_permlane32_swap(__float_as_uint(v), __float_as_uint(v), false, false); return __uint_as_float(rr[0]) + __uint_as_float(rr[1]); }
__device__ __forceinline__ s16x4 vtr(const LAS3 unsigned char* p) { typedef short v4i16_t __attribute__((ext_vector_type(4))); return __builtin_bit_cast(s16x4, __builtin_amdgcn_ds_read_tr16_b64_v4i16((LAS3 v4i16_t*)p)); }

struct Ptrs {
    const bf16_t* Q; int qp, qh;
    const bf16_t* K; int kp, kh;
    const bf16_t* K2; int k2p;
    const bf16_t* V; int vp, vh;
    bf16_t* O; int oc;
    const float* bias;
    const float* kmax;
};

template <int VAR>
__device__ __forceinline__ void attn_unit(const Ptrs& P, int b, int h, int qb, LAS3 unsigned char* lds) {
    constexpr int DQ = (VAR == 2) ? 96 : 64, ND = DQ / 16, KP = DQ * 2 + 16;
    constexpr bool DESC = (VAR == 1 || VAR == 3);
    int tid_ = threadIdx.x; asm volatile("" : "+v"(tid_)); const int tid = tid_, lane = tid & 63, r32 = lane & 31, hi = lane >> 5; const int wid = __builtin_amdgcn_readfirstlane(tid >> 6);
    const size_t rowbase = (size_t)b * SEQ; const int q0 = qb * 256, qrow = q0 + wid * 32 + r32;
    const int cw = 4 * qb + (wid >> 1);
    const int t_hi = 4 * qb + 3, t_lo = (VAR == 0) ? ((4 * qb - 8) > 0 ? (4 * qb - 8) : 0) : 0, nt = t_hi - t_lo + 1;
    const int w_lo = (VAR == 0) ? ((cw - 8) > 0 ? (cw - 8) : 0) : 0, w_hi = cw;
    LAS3 float* TB = (LAS3 float*)(lds + TB_OFF);
    if (VAR == 0) { for (int i = tid; i < 257; i += 512) TB[i] = P.bias[h * 257 + i] * LOG2E; }
    volatile LAS3 unsigned* donec = (volatile LAS3 unsigned*)(lds + FLAG_OFF);
    bool wdone = false; int dp = 0;
    if (DESC) { if (tid == 0) donec[0] = 0u; }
    bf16x8 qf[ND];
    { const bf16_t* qp = P.Q + (rowbase + qrow) * P.qp + h * P.qh + hi * 8;
#pragma unroll
      for (int d0 = 0; d0 < ND; ++d0) qf[d0] = *(const bf16x8*)(qp + d0 * 16); }
    float qk_bound = 0.f;
    if (VAR == 3) { float s2_ = 0.f;
#pragma unroll
        for (int d0 = 0; d0 < ND; ++d0)
#pragma unroll
            for (int e = 0; e < 8; ++e) { const float v_ = __uint_as_float(((unsigned)(unsigned short)qf[d0][e]) << 16); s2_ += v_ * v_; }
        s2_ = lane32_sum(s2_); qk_bound = sqrtf(s2_) * P.kmax[b * 8 + h] * 1.001f; }
    const int lkey = tid >> 3, lj = tid & 7;
    const bf16_t* kg = P.K + (rowbase + lkey) * P.kp + h * P.kh + lj * 8;
    const bf16_t* vg = P.V + (rowbase + lkey) * P.vp + h * P.vh + lj * 8;
    const bf16_t* k2g = (VAR == 2) ? P.K2 + (rowbase + (tid >> 2)) * P.k2p + (tid & 3) * 8 : nullptr;
    const float* fg = (VAR == 3) ? P.bias + ((size_t)(b * 8 + h)) * SEQ + (tid & 15) * 4 : nullptr;
    const int kw = lkey * KP + lj * 16, vw = KBUF + (lj >> 2) * 4096 + lkey * 64 + (lj & 3) * 16, k2w = (tid >> 2) * KP + 128 + (tid & 3) * 16, fw = KBUF + VBUF + (tid & 15) * 16;
    u32x4 rk, rv, rk2; f32x4 rf;
#define ATT_LOAD(t) do { const size_t ko_ = (size_t)(t) * 64; rk = *(const u32x4*)(kg + ko_ * P.kp); rv = *(const u32x4*)(vg + ko_ * P.vp); \
        if (VAR == 2) { if (tid < 256) rk2 = *(const u32x4*)(k2g + ko_ * P.k2p); } if (VAR == 3) { if (tid < 16) rf = *(const f32x4*)(fg + ko_); } } while (0)
#define ATT_STORE(bufo) do { *(LAS3 u32x4*)(lds + (bufo) + kw) = rk; *(LAS3 u32x4*)(lds + (bufo) + vw) = rv; \
        if (VAR == 2) { if (tid < 256) *(LAS3 u32x4*)(lds + (bufo) + k2w) = rk2; } if (VAR == 3) { if (tid < 16) *(LAS3 f32x4*)(lds + (bufo) + fw) = rf; } } while (0)
    const int pi = (r32 & ~12) | ((r32 & 4) << 1) | ((r32 & 8) >> 1);
    const int ka = pi * KP + hi * 16;
    const int va = KBUF + (8 * hi + ((lane & 15) >> 2)) * 64 + (16 * ((lane >> 4) & 1) + 4 * (lane & 3)) * 2;
    float m_run = NEG_BIG, l_run = 0.f, R = 0.f;
    f32x16 ot0 = {}, ot1 = {};
    { const int t0 = DESC ? t_hi : t_lo; ATT_LOAD(t0); ATT_STORE(0); }
    __syncthreads();
    for (int it = 0; it < nt; ++it) {
        const int t = DESC ? (t_hi - it) : (t_lo + it);
        const int bufo = (it & 1) * BUFB, nbufo = BUFB - bufo;
        const bool more = (it + 1 < nt);
        if (more) { const int tn = DESC ? (t - 1) : (t + 1); ATT_LOAD(tn); }
        if (DESC) { if (tid == 0) donec[dp == 2 ? 0 : dp + 1] = 0u; }
        if (t >= w_lo && t <= w_hi && !(DESC && wdone)) {
            f32x16 sa = {}, sb = {};
            const LAS3 unsigned char* kb = lds + bufo + ka;
#pragma unroll
            for (int d0 = 0; d0 < ND; ++d0) {
                const bf16x8 k0 = *(const LAS3 bf16x8*)(kb + d0 * 32), k1 = *(const LAS3 bf16x8*)(kb + 32 * KP + d0 * 32);
                sa = __builtin_amdgcn_mfma_f32_32x32x16_bf16(k0, qf[d0], sa, 0, 0, 0);
                sb = __builtin_amdgcn_mfma_f32_32x32x16_bf16(k1, qf[d0], sb, 0, 0, 0);
            }
            bf16x8 pk[4];
            if (VAR != 1) {
                if (VAR == 0) {
                    if (cw - t >= 3) { const float c = TB[256];
#pragma unroll
                        for (int r = 0; r < 16; ++r) { sa[r] += c; sb[r] += c; } }
                    else { const int d0_ = qrow - 64 * t - 8 * hi + 128;
#pragma unroll
                        for (int r = 0; r < 16; ++r) { int ia = d0_ - 16 * (r >> 3) - (r & 7), ib = ia - 32; ia = ia < 0 ? 0 : (ia > 256 ? 256 : ia); ib = ib < 0 ? 0 : (ib > 256 ? 256 : ib);
                            sa[r] += TB[ia]; sb[r] += TB[ib]; } }
                }
                if (VAR == 3) {
                    const LAS3 float* F = (const LAS3 float*)(lds + bufo + KBUF + VBUF) + 8 * hi;
#pragma unroll
                    for (int a = 0; a < 2; ++a) {
                        const f32x4 fa0 = *(const LAS3 f32x4*)(F + 16 * a), fa1 = *(const LAS3 f32x4*)(F + 16 * a + 4), fb0 = *(const LAS3 f32x4*)(F + 32 + 16 * a), fb1 = *(const LAS3 f32x4*)(F + 32 + 16 * a + 4);
#pragma unroll
                        for (int e = 0; e < 4; ++e) { sa[8 * a + e] -= fa0[e]; sa[8 * a + 4 + e] -= fa1[e]; sb[8 * a + e] -= fb0[e]; sb[8 * a + 4 + e] -= fb1[e]; }
                    }
                    if (t == cw) { const int lim = qrow - 64 * t - 8 * hi;
#pragma unroll
                        for (int r = 0; r < 16; ++r) { const int kk = 16 * (r >> 3) + (r & 7); if (kk > lim) sa[r] = NEG_BIG; if (kk + 32 > lim) sb[r] = NEG_BIG; } }
                }
                float mx = fmaxf(sa[0], sb[0]);
#pragma unroll
                for (int r = 1; r < 16; ++r) mx = fmaxf(mx, fmaxf(sa[r], sb[r]));
                mx = lane32_max(mx);
                const float m_new = fmaxf(m_run, mx), alpha = __builtin_amdgcn_exp2f(m_run - m_new); m_run = m_new;
                float ls = 0.f;
#pragma unroll
                for (int r = 0; r < 16; ++r) { sa[r] = __builtin_amdgcn_exp2f(sa[r] - m_new); sb[r] = __builtin_amdgcn_exp2f(sb[r] - m_new); ls += sa[r] + sb[r]; }
                l_run = l_run * alpha + ls;
#pragma unroll
                for (int r = 0; r < 16; ++r) { ot0[r] *= alpha; ot1[r] *= alpha; }
                if (VAR == 3) {
                    const float f0_ = *((const LAS3 float*)(lds + bufo + KBUF + VBUF));
                    if (__all(qk_bound - f0_ - m_run < -160.0f) || t == 0) wdone = true;
                }
            } else {
                const int lim = (t == cw) ? (qrow - 64 * t - 8 * hi) : 1000;
                float seg[4];
#pragma unroll
                for (int a = 0; a < 4; ++a) { float run = 0.f;
#pragma unroll
                    for (int j = 7; j >= 0; --j) { const int r = 8 * (a & 1) + j; const float z = (a < 2) ? sa[r] : sb[r]; const int kk = 16 * a + j;
                        const float sp = fmaxf(z, 0.f) + __logf(1.0f + __expf(-fabsf(z)));
                        const bool vis = kk < lim;
                        const float lb = z - sp + run;
                        if (a < 2) sa[r] = vis ? lb : NEG_BIG; else sb[r] = vis ? lb : NEG_BIG;
                        run += vis ? -sp : 0.f; }
                    seg[a] = run; }
                float oth[4];
#pragma unroll
                for (int a = 0; a < 4; ++a) oth[a] = lane32_other(seg[a]);
                float off[4]; float accu = R;
#pragma unroll
                for (int a = 3; a >= 0; --a) { if (hi) { off[a] = accu; accu += seg[a] + oth[a]; } else { off[a] = accu + oth[a]; accu += seg[a] + oth[a]; } }
                R = accu;
                if (__all(R < -105.0f) || t == 0) wdone = true;
#pragma unroll
                for (int r = 0; r < 8; ++r) { sa[r] = __expf(sa[r] + off[0]); sa[8 + r] = __expf(sa[8 + r] + off[1]); sb[r] = __expf(sb[r] + off[2]); sb[8 + r] = __expf(sb[8 + r] + off[3]); }
            }
            { u32x4 w;
              w.x = pk2(sa[0], sa[1]); w.y = pk2(sa[2], sa[3]); w.z = pk2(sa[4], sa[5]); w.w = pk2(sa[6], sa[7]); pk[0] = __builtin_bit_cast(bf16x8, w);
              w.x = pk2(sa[8], sa[9]); w.y = pk2(sa[10], sa[11]); w.z = pk2(sa[12], sa[13]); w.w = pk2(sa[14], sa[15]); pk[1] = __builtin_bit_cast(bf16x8, w);
              w.x = pk2(sb[0], sb[1]); w.y = pk2(sb[2], sb[3]); w.z = pk2(sb[4], sb[5]); w.w = pk2(sb[6], sb[7]); pk[2] = __builtin_bit_cast(bf16x8, w);
              w.x = pk2(sb[8], sb[9]); w.y = pk2(sb[10], sb[11]); w.z = pk2(sb[12], sb[13]); w.w = pk2(sb[14], sb[15]); pk[3] = __builtin_bit_cast(bf16x8, w); }
            const LAS3 unsigned char* vb = lds + bufo + va;
#pragma unroll
            for (int s = 0; s < 4; ++s) {
                const s16x4 a0 = vtr(vb + s * 1024), a1 = vtr(vb + s * 1024 + 256), c0 = vtr(vb + 4096 + s * 1024), c1 = vtr(vb + 4096 + s * 1024 + 256);
                const bf16x8 v0 = {a0[0], a0[1], a0[2], a0[3], a1[0], a1[1], a1[2], a1[3]}, v1 = {c0[0], c0[1], c0[2], c0[3], c1[0], c1[1], c1[2], c1[3]};
                ot0 = __builtin_amdgcn_mfma_f32_32x32x16_bf16(v0, pk[s], ot0, 0, 0, 0);
                ot1 = __builtin_amdgcn_mfma_f32_32x32x16_bf16(v1, pk[s], ot1, 0, 0, 0);
            }
        }
        if (more) ATT_STORE(nbufo);
        if (DESC) { if (wdone && lane == 0) __hip_atomic_fetch_add((LAS3 unsigned*)(lds + FLAG_OFF) + dp, 1u, __ATOMIC_RELAXED, __HIP_MEMORY_SCOPE_WORKGROUP); }
        __syncthreads();
        if (DESC) { if (donec[dp] == 8u) break; dp = (dp == 2) ? 0 : dp + 1; }
    }
#undef ATT_LOAD
#undef ATT_STORE
    float inv = 1.f;
    if (VAR != 1) { const float lt = lane32_sum(l_run); inv = 1.0f / lt; }
    bf16_t* op = P.O + (rowbase + qrow) * DM + P.oc + h * 64 + 4 * hi;
#pragma unroll
    for (int a = 0; a < 4; ++a) {
        u32x2 w0, w1; w0.x = pk2(ot0[4 * a] * inv, ot0[4 * a + 1] * inv); w0.y = pk2(ot0[4 * a + 2] * inv, ot0[4 * a + 3] * inv);
        w1.x = pk2(ot1[4 * a] * inv, ot1[4 * a + 1] * inv); w1.y = pk2(ot1[4 * a + 2] * inv, ot1[4 * a + 3] * inv);
        *(u32x2*)(op + 8 * a) = w0; *(u32x2*)(op + 32 + 8 * a) = w1;
    }
}

template <int VAR>
__device__ __forceinline__ void attn_unit_sm(const Ptrs& P, int b, int h, int qb, LAS3 unsigned char* lds) {
    constexpr int DQ = (VAR == 2) ? 96 : 64, ND = DQ / 16, KP = DQ * 2 + 16;
    int tid_ = threadIdx.x; asm volatile("" : "+v"(tid_)); const int tid = tid_, lane = tid & 63, r32 = lane & 31, hi = lane >> 5; const int wid = __builtin_amdgcn_readfirstlane(tid >> 6);
    const size_t rowbase = (size_t)b * SEQ; const int q0 = qb * 256, qrow = q0 + wid * 32 + r32;
    const int cw = 4 * qb + (wid >> 1);
    const int t_hi = 4 * qb + 3, t_lo = (VAR == 0) ? ((4 * qb - 8) > 0 ? (4 * qb - 8) : 0) : 0, nt = t_hi - t_lo + 1;
    const int w_lo = (VAR == 0) ? ((cw - 8) > 0 ? (cw - 8) : 0) : 0, w_hi = cw;
    LAS3 float* TB = (LAS3 float*)(lds + TB_OFF);
    if (VAR == 0) { for (int i = tid; i < 257; i += 512) TB[i] = P.bias[h * 257 + i] * LOG2E; }
    bf16x8 qf[ND];
    { const bf16_t* qp = P.Q + (rowbase + qrow) * P.qp + h * P.qh + hi * 8;
#pragma unroll
      for (int d0 = 0; d0 < ND; ++d0) qf[d0] = *(const bf16x8*)(qp + d0 * 16); }
    const float cbase = (VAR == 3) ? P.bias[((size_t)(b * 8 + h)) * SEQ + qrow] : 0.f;
    const int lkey = tid >> 3, lj = tid & 7;
    const bf16_t* kg = P.K + (rowbase + lkey) * P.kp + h * P.kh + lj * 8;
    const bf16_t* vg = P.V + (rowbase + lkey) * P.vp + h * P.vh + lj * 8;
    const bf16_t* k2g = (VAR == 2) ? P.K2 + (rowbase + (tid >> 2)) * P.k2p + (tid & 3) * 8 : nullptr;
    const float* fg = (VAR == 3) ? P.bias + ((size_t)(b * 8 + h)) * SEQ + (tid & 15) * 4 : nullptr;
    const int kw = lkey * KP + lj * 16, vw = KBUF + (lj >> 2) * 4096 + lkey * 64 + (lj & 3) * 16, k2w = (tid >> 2) * KP + 128 + (tid & 3) * 16, fw = KBUF + VBUF + (tid & 15) * 16;
    u32x4 rk0, rv0, rk20, rk1, rv1, rk21; f32x4 rf0, rf1;
#define ATT_LOAD(t, S) do { const size_t ko_ = (size_t)(t) * 64; rk##S = *(const u32x4*)(kg + ko_ * P.kp); rv##S = *(const u32x4*)(vg + ko_ * P.vp); \
        if (VAR == 2) { if (tid < 256) rk2##S = *(const u32x4*)(k2g + ko_ * P.k2p); } if (VAR == 3) { if (tid < 16) rf##S = *(const f32x4*)(fg + ko_); } } while (0)
#define ATT_STORE(bufo, S) do { *(LAS3 u32x4*)(lds + (bufo) + kw) = rk##S; *(LAS3 u32x4*)(lds + (bufo) + vw) = rv##S; \
        if (VAR == 2) { if (tid < 256) *(LAS3 u32x4*)(lds + (bufo) + k2w) = rk2##S; } if (VAR == 3) { if (tid < 16) *(LAS3 f32x4*)(lds + (bufo) + fw) = rf##S; } } while (0)
    const int pi = (r32 & ~12) | ((r32 & 4) << 1) | ((r32 & 8) >> 1);
    const int ka = pi * KP + hi * 16;
    const int va = KBUF + (8 * hi + ((lane & 15) >> 2)) * 64 + (16 * ((lane >> 4) & 1) + 4 * (lane & 3)) * 2;
    float m_run = 0.f, l_run = 0.f;
    f32x16 ot0 = {}, ot1 = {}, negm;
#pragma unroll
    for (int r = 0; r < 16; ++r) negm[r] = cbase;
    asm volatile("" : "+v"(negm));
    f32x16 sA0 = {}, sA1 = {}, sB0 = {}, sB1 = {};
#define SM_QK(SA, SB, kbo) do { const LAS3 unsigned char* kb_ = lds + (kbo) + ka; __builtin_amdgcn_s_setprio(1); \
        _Pragma("unroll") for (int d0 = 0; d0 < ND; ++d0) { \
            const bf16x8 k0_ = *(const LAS3 bf16x8*)(kb_ + d0 * 32), k1_ = *(const LAS3 bf16x8*)(kb_ + 32 * KP + d0 * 32); \
            if (d0 == 0) { SA = __builtin_amdgcn_mfma_f32_32x32x16_bf16(k0_, qf[0], negm, 0, 0, 0); SB = __builtin_amdgcn_mfma_f32_32x32x16_bf16(k1_, qf[0], negm, 0, 0, 0); } \
            else { SA = __builtin_amdgcn_mfma_f32_32x32x16_bf16(k0_, qf[d0], SA, 0, 0, 0); SB = __builtin_amdgcn_mfma_f32_32x32x16_bf16(k1_, qf[d0], SB, 0, 0, 0); } } __builtin_amdgcn_s_setprio(0); } while (0)
#define SM_BIAS(SA, SB, tn, bo) do { \
        if (VAR == 0) { \
            if (cw - (tn) >= 3) { const float c_ = TB[256]; _Pragma("unroll") for (int r = 0; r < 16; ++r) { SA[r] += c_; SB[r] += c_; } } \
            else { const int d0_ = qrow - 64 * (tn) - 8 * hi + 128; \
                _Pragma("unroll") for (int r = 0; r < 16; ++r) { int ia = d0_ - 16 * (r >> 3) - (r & 7), ib = ia - 32; ia = ia < 0 ? 0 : (ia > 256 ? 256 : ia); ib = ib < 0 ? 0 : (ib > 256 ? 256 : ib); \
                    SA[r] += TB[ia]; SB[r] += TB[ib]; } } } \
        if (VAR == 3) { const LAS3 float* F_ = (const LAS3 float*)(lds + (bo) + KBUF + VBUF) + 8 * hi; \
            _Pragma("unroll") for (int a = 0; a < 2; ++a) { \
                const f32x4 fa0 = *(const LAS3 f32x4*)(F_ + 16 * a), fa1 = *(const LAS3 f32x4*)(F_ + 16 * a + 4), fb0 = *(const LAS3 f32x4*)(F_ + 32 + 16 * a), fb1 = *(const LAS3 f32x4*)(F_ + 32 + 16 * a + 4); \
                _Pragma("unroll") for (int e = 0; e < 4; ++e) { SA[8 * a + e] -= fa0[e]; SA[8 * a + 4 + e] -= fa1[e]; SB[8 * a + e] -= fb0[e]; SB[8 * a + 4 + e] -= fb1[e]; } } \
            if ((tn) >= cw) { const int lim_ = qrow - 64 * (tn) - 8 * hi; \
                _Pragma("unroll") for (int r = 0; r < 16; ++r) { const int kk = 16 * (r >> 3) + (r & 7); if (kk > lim_) SA[r] = NEG_BIG; if (kk + 32 > lim_) SB[r] = NEG_BIG; } } } } while (0)
#define SM_BIAS_C(SA, SB, tn) do { if (VAR == 2) { if ((tn) > cw) { _Pragma("unroll") for (int r = 0; r < 16; ++r) { SA[r] = NEG_BIG; SB[r] = NEG_BIG; } } } } while (0)
#define SM_REF(SA, SB, HASN, NA, NB) do { \
        float mx_ = fmaxf(SA[0], SB[0]); _Pragma("unroll") for (int r = 1; r < 16; ++r) mx_ = fmaxf(mx_, fmaxf(SA[r], SB[r])); \
        mx_ = lane32_max(mx_); \
        if (__any(mx_ > 8.0f)) { const float dl_ = fmaxf(mx_, 0.f); m_run += dl_; \
            _Pragma("unroll") for (int r = 0; r < 16; ++r) { SA[r] -= dl_; SB[r] -= dl_; } \
            if (HASN) { _Pragma("unroll") for (int r = 0; r < 16; ++r) { NA[r] -= dl_; NB[r] -= dl_; } } \
            const float nm_ = cbase - m_run; _Pragma("unroll") for (int r = 0; r < 16; ++r) negm[r] = nm_; asm volatile("" : "+v"(negm)); \
            { const float f_ = __builtin_amdgcn_exp2f(-dl_); l_run *= f_; _Pragma("unroll") for (int r = 0; r < 16; ++r) { ot0[r] *= f_; ot1[r] *= f_; } } } } while (0)
#define SM_PV(SA, SB, vbo) do { const LAS3 unsigned char* vb_ = lds + (vbo) + va; float ls_ = 0.f; \
        _Pragma("unroll") for (int s = 0; s < 4; ++s) { u32x4 w_; \
            _Pragma("unroll") for (int j = 0; j < 4; ++j) { float e0_, e1_; \
                if (s < 2) { e0_ = __builtin_amdgcn_exp2f(SA[8 * (s & 1) + 2 * j]); e1_ = __builtin_amdgcn_exp2f(SA[8 * (s & 1) + 2 * j + 1]); } \
                else { e0_ = __builtin_amdgcn_exp2f(SB[8 * (s & 1) + 2 * j]); e1_ = __builtin_amdgcn_exp2f(SB[8 * (s & 1) + 2 * j + 1]); } \
                ls_ += e0_ + e1_; w_[j] = pk2(e0_, e1_); } \
            const bf16x8 p_ = __builtin_bit_cast(bf16x8, w_); \
            const s16x4 a0 = vtr(vb_ + s * 1024), a1 = vtr(vb_ + s * 1024 + 256), c0 = vtr(vb_ + 4096 + s * 1024), c1 = vtr(vb_ + 4096 + s * 1024 + 256); \
            const bf16x8 v0 = {a0[0], a0[1], a0[2], a0[3], a1[0], a1[1], a1[2], a1[3]}, v1 = {c0[0], c0[1], c0[2], c0[3], c1[0], c1[1], c1[2], c1[3]}; \
            ot0 = __builtin_amdgcn_mfma_f32_32x32x16_bf16(v0, p_, ot0, 0, 0, 0); \
            ot1 = __builtin_amdgcn_mfma_f32_32x32x16_bf16(v1, p_, ot1, 0, 0, 0); } \
        l_run += ls_; } while (0)
#define SM_STEP(CA, CB, NA, NB, it, LS, SS) do { \
        const bool more_ = ((it) + 2 < nt); \
        if ((it) + 3 < nt) ATT_LOAD((it) + 3, LS); \
        SM_REF(CA, CB, false, NA, NB); SM_QK(NA, NB, b_next); SM_PV(CA, CB, b_cur); SM_BIAS(NA, NB, (it) + 1, b_next); SM_BIAS_C(NA, NB, (it) + 1); \
        if (more_) ATT_STORE(b_store, SS); \
        asm volatile("s_waitcnt lgkmcnt(0)\n\ts_barrier" ::: "memory");     \
        { const int tb_ = b_cur; b_cur = b_next; b_next = b_store; b_store = tb_; } } while (0)
    ATT_LOAD(0, 0); ATT_LOAD(1, 1); ATT_STORE(0, 0); ATT_STORE(BUFB, 1); ATT_LOAD(2, 1);
    __syncthreads();
    int b_cur = 0, b_next = BUFB, b_store = 2 * BUFB;
    SM_QK(sA0, sA1, 0); SM_BIAS(sA0, sA1, 0, 0);
    { float mx_ = fmaxf(sA0[0], sA1[0]);
#pragma unroll
      for (int r = 1; r < 16; ++r) mx_ = fmaxf(mx_, fmaxf(sA0[r], sA1[r]));
      mx_ = lane32_max(mx_); m_run = mx_;
#pragma unroll
      for (int r = 0; r < 16; ++r) { sA0[r] -= mx_; sA1[r] -= mx_; negm[r] = cbase - mx_; }
      asm volatile("" : "+v"(negm)); }
    int it = 0;
    for (; it + 2 < nt; it += 2) {
        SM_STEP(sA0, sA1, sB0, sB1, it, 0, 1);
        SM_STEP(sB0, sB1, sA0, sA1, it + 1, 1, 0);
    }
    SM_STEP(sA0, sA1, sB0, sB1, it, 0, 1);
    SM_REF(sB0, sB1, false, sA0, sA1); SM_PV(sB0, sB1, b_cur);
    __syncthreads();
#undef SM_STEP
#undef SM_PV
#undef SM_REF
#undef SM_BIAS
#undef SM_BIAS_C
#undef SM_QK
#undef ATT_LOAD
#undef ATT_STORE
    const float lt = lane32_sum(l_run); const float inv = 1.0f / lt;
    bf16_t* op = P.O + (rowbase + qrow) * DM + P.oc + h * 64 + 4 * hi;
#pragma unroll
    for (int a = 0; a < 4; ++a) {
        u32x2 w0, w1; w0.x = pk2(ot0[4 * a] * inv, ot0[4 * a + 1] * inv); w0.y = pk2(ot0[4 * a + 2] * inv, ot0[4 * a + 3] * inv);
        w1.x = pk2(ot1[4 * a] * inv, ot1[4 * a + 1] * inv); w1.y = pk2(ot1[4 * a + 2] * inv, ot1[4 * a + 3] * inv);
        *(u32x2*)(op + 8 * a) = w0; *(u32x2*)(op + 32 + 8 * a) = w1;
    }
}
}
#define LAS __attribute__((address_space(3)))
typedef unsigned short bf16;
typedef unsigned v4u __attribute__((ext_vector_type(4)));
typedef float f32x4 __attribute__((ext_vector_type(4)));
typedef float f32x2 __attribute__((ext_vector_type(2)));
constexpr int NWAVES = 8, NTHR = 512;
constexpr size_t MiB = 1u << 20;
constexpr size_t WS_SS = 0;
constexpr size_t WS_QCTR = 7 * 131072;
constexpr size_t WS_BAR = WS_QCTR + 64 * 256;
constexpr size_t WS_KMAX = WS_BAR + 3456 * 4;
constexpr size_t WS_ROPE = 1 * MiB;
constexpr size_t WS_LF = 2 * MiB;
constexpr size_t WS_CUMF = 3 * MiB;
constexpr size_t WS_W_AB = 4 * MiB, WS_W_OAB = 10 * MiB, WS_W_GU0 = 12 * MiB, WS_W_DN0 = 23 * MiB, WS_W_CD = 29 * MiB, WS_W_UQ = 34 * MiB, WS_W_UKV = 35 * MiB,
                 WS_W_OCD = 36 * MiB, WS_W_GU1 = 38 * MiB, WS_W_DN1 = 49 * MiB;
constexpr size_t WS_XB = 56 * MiB;
constexpr size_t WS_BIG = 120 * MiB;
constexpr size_t WS_END = 472 * MiB;
constexpr int RING_BYTES = 131072, LDS_BYTES = 147456;

struct Args {
    const float *x, *ab_norm, *ab_w_in, *ab_rel_bias, *ab_w_o, *cd_norm, *cd_w_in, *cd_q_norm, *cd_w_uq, *cd_kv_norm, *cd_w_ukv, *cd_b_f, *cd_w_o,
                *ffn_norm, *ffn_w_gate, *ffn_w_up, *ffn_conv_w, *ffn_conv_b, *ffn_w_down, *final_norm;
    float* out; unsigned char* ws;
};

__device__ __forceinline__ unsigned f2bf(float f) { unsigned u = __builtin_bit_cast(unsigned, f); return (u + 0x7fffu + ((u >> 16) & 1u)) >> 16; }
__device__ __forceinline__ unsigned pk2f(float lo, float hi) { return f2bf(lo) | (f2bf(hi) << 16); }
__device__ __forceinline__ float bf_lo(unsigned w) { return __uint_as_float(w << 16); }
__device__ __forceinline__ float bf_hi(unsigned w) { return __uint_as_float(w & 0xffff0000u); }
__device__ __forceinline__ float wave_sum(float v) {
#pragma unroll
    for (int o = 1; o < 64; o <<= 1) v += __shfl_xor(v, o);
    return v;
}

struct WDesc { const float* W; int K, N, Npad; bf16* WT; int row_off; int ilv; const float* gain; int s0lo, s0hi; float s0; int s1lo, s1hi; float s1; };
__device__ __forceinline__ void transpose_item(const WDesc& d, LAS float* scr, int item, int lane) {
    const int nblk = d.Npad / 32, kb = item / nblk, nb = item % nblk, k0 = 64 * kb, n0 = 32 * nb;
    const int n = n0 + (lane & 31);
    const float cs = (n >= d.s0lo && n < d.s0hi) ? d.s0 : ((n >= d.s1lo && n < d.s1hi) ? d.s1 : 1.0f);
    float wv[32];
#pragma unroll
    for (int i = 0; i < 32; ++i) { const int kk = 2 * i + (lane >> 5); wv[i] = (n < d.N) ? d.W[(size_t)(k0 + kk) * d.N + n] : 0.f; }
    const float g0 = d.gain ? d.gain[k0 + lane] : 1.0f;
#pragma unroll
    for (int i = 0; i < 32; ++i) { const int kk = 2 * i + (lane >> 5); const float g = __shfl(g0, kk); scr[kk * 33 + (lane & 31)] = wv[i] * g * cs; }
    asm volatile("s_waitcnt lgkmcnt(0)" ::: "memory");
    const int c = lane & 7;
#pragma unroll
    for (int j = 0; j < 4; ++j) { const int nn = (lane >> 3) + 8 * j; const LAS float* s = scr + (8 * c) * 33 + nn;
        v4u o; o.x = pk2f(s[0 * 33], s[1 * 33]); o.y = pk2f(s[2 * 33], s[3 * 33]); o.z = pk2f(s[4 * 33], s[5 * 33]); o.w = pk2f(s[6 * 33], s[7 * 33]);
        const int rowb = d.ilv ? (256 * (n0 >> 7) + (n0 & 127) + d.row_off) : (d.row_off + n0);
        *(v4u*)(d.WT + (size_t)(rowb + nn) * d.K + k0 + 8 * c) = o; }
    asm volatile("s_waitcnt lgkmcnt(0)" ::: "memory");
}
__device__ __forceinline__ WDesc wdesc(const Args& a, int mi) {
    unsigned char* ws = a.ws; WDesc d; d.gain = nullptr; d.row_off = 0; d.ilv = 0; d.s0lo = d.s0hi = d.s1lo = d.s1hi = 0; d.s0 = d.s1 = 1.f;
    switch (mi) {
    case 0: d.W = a.ab_w_in; d.K = DM; d.N = AB_COLS; d.Npad = AB_COLS; d.WT = (bf16*)(ws + WS_W_AB); d.gain = a.ab_norm; d.s0lo = 0; d.s0hi = 512; d.s0 = 0.125f * LOG2E; d.s1lo = 1536; d.s1hi = 2048; d.s1 = 0.125f; break;
    case 1: d.W = a.ab_w_o; d.K = DM; d.N = DM; d.Npad = DM; d.WT = (bf16*)(ws + WS_W_OAB); break;
    case 2: d.W = a.ffn_w_gate; d.K = DM; d.N = FF; d.Npad = FF; d.WT = (bf16*)(ws + WS_W_GU0); d.gain = a.ffn_norm; d.ilv = 1; break;
    case 3: d.W = a.ffn_w_up; d.K = DM; d.N = FF; d.Npad = FF; d.WT = (bf16*)(ws + WS_W_GU0); d.row_off = 128; d.ilv = 1; d.gain = a.ffn_norm; break;
    case 4: d.W = a.ffn_w_down; d.K = FF; d.N = DM; d.Npad = DM; d.WT = (bf16*)(ws + WS_W_DN0); break;
    case 5: d.W = a.cd_w_in; d.K = DM; d.N = CD_COLS; d.Npad = CD_PAD; d.WT = (bf16*)(ws + WS_W_CD); d.gain = a.cd_norm; d.s0lo = 672; d.s0hi = 1184; d.s0 = 0.125f * LOG2E; break;
    case 6: d.W = a.cd_w_uq; d.K = Q_RANK; d.N = QC_COLS; d.Npad = QC_COLS; d.WT = (bf16*)(ws + WS_W_UQ); d.gain = a.cd_q_norm; d.s0lo = 0; d.s0hi = QC_COLS; d.s0 = 0.10206207261596575f * LOG2E; break;
    case 7: d.W = a.cd_w_ukv; d.K = KV_RANK; d.N = KVC_COLS; d.Npad = KVC_COLS; d.WT = (bf16*)(ws + WS_W_UKV); d.gain = a.cd_kv_norm; break;
    case 8: d.W = a.cd_w_o; d.K = DM; d.N = DM; d.Npad = DM; d.WT = (bf16*)(ws + WS_W_OCD); break;
    case 9: d.W = a.ffn_w_gate + (size_t)DM * FF; d.K = DM; d.N = FF; d.Npad = FF; d.WT = (bf16*)(ws + WS_W_GU1); d.gain = a.ffn_norm + DM; d.ilv = 1; break;
    case 10: d.W = a.ffn_w_up + (size_t)DM * FF; d.K = DM; d.N = FF; d.Npad = FF; d.WT = (bf16*)(ws + WS_W_GU1); d.row_off = 128; d.ilv = 1; d.gain = a.ffn_norm + DM; break;
    default: d.W = a.ffn_w_down + (size_t)FF * DM; d.K = FF; d.N = DM; d.Npad = DM; d.WT = (bf16*)(ws + WS_W_DN1); break;
    }
    return d;
}
__device__ __forceinline__ int witems(int mi) {
    switch (mi) { case 0: return (DM / 64) * (AB_COLS / 32); case 1: case 8: return (DM / 64) * (DM / 32); case 2: case 3: case 9: case 10: return (DM / 64) * (FF / 32);
                  case 4: case 11: return (FF / 64) * (DM / 32); case 5: return (DM / 64) * (CD_PAD / 32); case 6: return (Q_RANK / 64) * (QC_COLS / 32); default: return (KV_RANK / 64) * (KVC_COLS / 32); }
}

__device__ __forceinline__ void p0_prologue(const Args& a, LAS unsigned char* lds, int gw, int NGW, int lane, int wave) {
    unsigned char* ws = a.ws;
    { float* z = (float*)(ws + WS_SS); const int gt = gw * 64 + lane, GT = NGW * 64;
      for (int i = MTOK + gt; i < 7 * MTOK + 64 * 64 + 3456 + 64; i += GT) z[i] = 0.f; }
    { f32x2* rt = (f32x2*)(ws + WS_ROPE); const int gt = gw * 64 + lane, GT = NGW * 64;
      for (int i = gt; i < SEQ * 16; i += GT) { const int pos = i >> 4, j = i & 15;
          const float inv = exp2f(-(float)j * (13.287712379549449f / 16.0f));
          const float ang = (float)pos * inv;
          const double turns = (double)ang * 0.15915494309189535; const float fr = (float)(turns - floor(turns));
          rt[i] = (f32x2){__builtin_amdgcn_cosf(fr), __builtin_amdgcn_sinf(fr)}; } }
    LAS float* scr = (LAS float*)(lds + wave * 16384);
    { int base = 0;
      for (int mi = 0; mi < 12; ++mi) { const int ni = witems(mi); const WDesc d = wdesc(a, mi);
          int first = gw - (base % NGW); if (first < 0) first += NGW;
          for (int it = first; it < ni; it += NGW) transpose_item(d, scr, it, lane);
          base += ni; } }
    { float* ss0 = (float*)(ws + WS_SS); bf16* xb = (bf16*)(ws + WS_XB);
      for (int m0 = gw * 4; m0 < MTOK; m0 += NGW * 4) {
          f32x4 v[4][4];
#pragma unroll
          for (int r = 0; r < 4; ++r) { const f32x4* xr = (const f32x4*)(a.x + (size_t)(m0 + r) * DM) + lane;
#pragma unroll
              for (int j = 0; j < 4; ++j) v[r][j] = __builtin_nontemporal_load(xr + 64 * j); }
#pragma unroll
          for (int r = 0; r < 4; ++r) { unsigned long long* o8 = (unsigned long long*)(xb + (size_t)(m0 + r) * DM) + lane; float s = 0.f;
#pragma unroll
              for (int j = 0; j < 4; ++j) { const f32x4 w = v[r][j]; s += (w.x * w.x + w.y * w.y) + (w.z * w.z + w.w * w.w); o8[64 * j] = (unsigned long long)pk2f(w.x, w.y) | ((unsigned long long)pk2f(w.z, w.w) << 32); }
              s = wave_sum(s); if (lane == 0) ss0[m0 + r] = s; } } }
}

__device__ __forceinline__ void act_phase(bf16* gu, const float* cw, const float* cb, int gtid, int GT) {
    constexpr int NCH = FF / 8, RB = 32;
    for (int it = gtid; it < (MTOK / RB) * NCH; it += GT) {
        const int ch = it % NCH, rb = it / NCH, r0 = rb * RB, c = ch * 8;
        float w0[8], w1[8], w2[8], bb[8];
#pragma unroll
        for (int e = 0; e < 8; ++e) { w0[e] = cw[c + e]; w1[e] = cw[FF + c + e]; w2[e] = cw[2 * FF + c + e]; bb[e] = cb[c + e]; }
        float g2[8], g1[8];
        if ((r0 & (SEQ - 1)) == 0) {
#pragma unroll
            for (int e = 0; e < 8; ++e) { g2[e] = 0.f; g1[e] = 0.f; }
        } else {
            const v4u a2 = *(const v4u*)(gu + (size_t)(r0 - 2) * FF2 + c), a1 = *(const v4u*)(gu + (size_t)(r0 - 1) * FF2 + c);
            g2[0] = bf_lo(a2.x); g2[1] = bf_hi(a2.x); g2[2] = bf_lo(a2.y); g2[3] = bf_hi(a2.y); g2[4] = bf_lo(a2.z); g2[5] = bf_hi(a2.z); g2[6] = bf_lo(a2.w); g2[7] = bf_hi(a2.w);
            g1[0] = bf_lo(a1.x); g1[1] = bf_hi(a1.x); g1[2] = bf_lo(a1.y); g1[3] = bf_hi(a1.y); g1[4] = bf_lo(a1.z); g1[5] = bf_hi(a1.z); g1[6] = bf_lo(a1.w); g1[7] = bf_hi(a1.w);
        }
#pragma unroll 4
        for (int r = 0; r < RB; ++r) {
            bf16* gp = gu + (size_t)(r0 + r) * FF2 + c;
            const v4u ag = *(const v4u*)gp, au = *(const v4u*)(gp + FF);
            float g0[8], uu[8], y[8];
            g0[0] = bf_lo(ag.x); g0[1] = bf_hi(ag.x); g0[2] = bf_lo(ag.y); g0[3] = bf_hi(ag.y); g0[4] = bf_lo(ag.z); g0[5] = bf_hi(ag.z); g0[6] = bf_lo(ag.w); g0[7] = bf_hi(ag.w);
            uu[0] = bf_lo(au.x); uu[1] = bf_hi(au.x); uu[2] = bf_lo(au.y); uu[3] = bf_hi(au.y); uu[4] = bf_lo(au.z); uu[5] = bf_hi(au.z); uu[6] = bf_lo(au.w); uu[7] = bf_hi(au.w);
#pragma unroll
            for (int e = 0; e < 8; ++e) { const float xg = w0[e] * g2[e] + w1[e] * g1[e] + w2[e] * g0[e] + bb[e]; y[e] = xg * __builtin_amdgcn_rcpf(1.0f + __expf(-xg)) * uu[e]; g2[e] = g1[e]; g1[e] = g0[e]; }
            v4u o; o.x = pk2f(y[0], y[1]); o.y = pk2f(y[2], y[3]); o.z = pk2f(y[4], y[5]); o.w = pk2f(y[6], y[7]);
            *(v4u*)(gp + FF) = o;
        }
    }
}

__device__ __forceinline__ void ffn_fixup(const float* gf, const float* uf, const float* gl, const float* cw, const float* cb, bf16* Y, int gtid, int GT) {
    constexpr int NC4 = FF / 4, NG = MTOK / 64;
    for (int it = gtid; it < NG * 2 * NC4; it += GT) {
        const int c = (it % NC4) * 4, j = (it / NC4) & 1, g = it / (2 * NC4);
        const bool seq0 = (g & (SEQ / 64 - 1)) == 0;
        const f32x4 z = {0.f, 0.f, 0.f, 0.f};
        const f32x4 g0 = *(const f32x4*)(gf + (size_t)(g * 2 + j) * FF + c), u0 = *(const f32x4*)(uf + (size_t)(g * 2 + j) * FF + c);
        const f32x4 l0 = seq0 ? z : *(const f32x4*)(gl + (size_t)((g - 1) * 2 + 0) * FF + c), l1 = seq0 ? z : *(const f32x4*)(gl + (size_t)((g - 1) * 2 + 1) * FF + c);
        const f32x4 g1 = j ? *(const f32x4*)(gf + (size_t)(g * 2) * FF + c) : l1, g2 = j ? l1 : l0;
        const f32x4 w0 = *(const f32x4*)(cw + c), w1 = *(const f32x4*)(cw + FF + c), w2 = *(const f32x4*)(cw + 2 * FF + c), bb = *(const f32x4*)(cb + c);
        const f32x4 xg = w0 * g2 + w1 * g1 + w2 * g0 + bb; float y[4];
#pragma unroll
        for (int e = 0; e < 4; ++e) y[e] = xg[e] * __builtin_amdgcn_rcpf(1.0f + __expf(-xg[e])) * u0[e];
        unsigned long long o = (unsigned long long)pk2f(y[0], y[1]) | ((unsigned long long)pk2f(y[2], y[3]) << 32);
        *(unsigned long long*)(Y + (size_t)(g * 64 + j) * FF + c) = o;
    }
}

__device__ __forceinline__ void cumf_block(const float* lf, float* cumf, int bh, LAS float* scr, int tid) {
    const int b = bh >> 3, h = bh & 7, t0 = tid * 16, lane = tid & 63, wave = tid >> 6;
    float v[16]; float s = 0.f;
#pragma unroll
    for (int i = 0; i < 16; ++i) { s += lf[((size_t)b * SEQ + t0 + i) * 8 + h]; v[i] = s; }
    float incl = s;
#pragma unroll
    for (int o = 1; o < 64; o <<= 1) { const float up = __shfl_up(incl, o); if (lane >= o) incl += up; }
    if (lane == 63) scr[wave] = incl;
    __syncthreads();
    float woff = 0.f;
    for (int w = 0; w < wave; ++w) woff += scr[w];
    const float off = woff + incl - s;
    float* o = cumf + (size_t)bh * SEQ + t0;
#pragma unroll
    for (int i = 0; i < 16; ++i) o[i] = off + v[i];
    __syncthreads();
}

__device__ __forceinline__ void kmax_block(const bf16* kd  , unsigned* kmax_bits, int blk, int tid) {
    const int bh = blk >> 3, seg = blk & 7, b = bh >> 3, h = bh & 7, lj = tid & 7, kl = tid >> 3;
    const bf16* p = kd + ((size_t)b * SEQ + seg * 1024 + kl) * CD_PAD + h * 64 + lj * 8;
    v4u w[16];
#pragma unroll
    for (int i = 0; i < 16; ++i) w[i] = *(const v4u*)(p + (size_t)i * 64 * CD_PAD);
    float mx = 0.f;
#pragma unroll
    for (int i = 0; i < 16; ++i) { float s = 0.f;
#pragma unroll
        for (int e = 0; e < 4; ++e) { const float lo = bf_lo(w[i][e]), hi = bf_hi(w[i][e]); s += lo * lo + hi * hi; }
        s += __shfl_xor(s, 1); s += __shfl_xor(s, 2); s += __shfl_xor(s, 4); mx = fmaxf(mx, s); }
#pragma unroll
    for (int o = 8; o < 64; o <<= 1) mx = fmaxf(mx, __shfl_xor(mx, o));
    if ((tid & 63) == 0) atomicMax(kmax_bits + bh, __float_as_uint(sqrtf(mx)));
}

template <int LAYER>
__device__ __forceinline__ void attn_phase(const att::Ptrs& P0, const att::Ptrs& P1, unsigned* ctr, LAS unsigned char* lds) {
    const int x0 = blockIdx.x & 7;
    volatile LAS int* qidx = (volatile LAS int*)(lds + att::QIDX_OFF);
#pragma unroll 1
    for (int q = 0; q < 8; ++q) {
        const int x = (x0 + q) & 7; unsigned* my = ctr + x * 64;
        for (;;) {
            if (threadIdx.x == 0) *qidx = (int)atomicAdd(my, 1u);
            __syncthreads();
            const int i = *qidx;
            __syncthreads();
            if (i >= 256) break;
            if (LAYER == 0) {
                if (i < 128) att::attn_unit<1>(P1, i & 3, x, 31 - (i >> 2), lds);
                else { const int j = i - 128; att::attn_unit<0>(P0, j >> 5, x, 31 - (j & 31), lds); }
            } else {
                const int j = i & 127, qb = 31 - (j >> 2), b = j & 3;
                if (i >= 128) att::attn_unit<3>(P1, b, x, qb, lds);
                else att::attn_unit_sm<2>(P0, b, x, qb, lds);
            }
        }
    }
}

typedef __attribute__((address_space(1))) unsigned gu32;
#define XB_TMO      128
#define XB_XCNT(j)  (256  + 64 * (j))
#define XB_XSUB(j)  (1280 + 64 * (j))
#define XB_XGEN(j)  (2304 + 64 * (j))
#define XB_TOP      3328
#define XB_TOPGEN   3392
#define XCD_BAR_WORDS 3456
#define XB_SPIN_CAP (1u << 18)

__device__ __forceinline__ unsigned xb_ld(unsigned* p)              { return __hip_atomic_load(p, __ATOMIC_RELAXED, __HIP_MEMORY_SCOPE_AGENT); }
__device__ __forceinline__ unsigned xb_add(unsigned* p, unsigned v) { return __hip_atomic_fetch_add(p, v, __ATOMIC_RELAXED, __HIP_MEMORY_SCOPE_AGENT); }
__device__ __forceinline__ unsigned xb_xcc_id() { return (unsigned)__builtin_amdgcn_s_getreg((3 << 11) | 20) & 0xFu; }
#define XB_SPIN(cond, bar) do { unsigned _sp = 0; while (cond) { __builtin_amdgcn_s_sleep(1); \
    if ((++_sp & 255u) == 0u) { if (xb_ld(&(bar)[XB_TMO])) break; if (_sp > XB_SPIN_CAP) { atomicAdd(&(bar)[XB_TMO], 1u); break; } } } } while (0)

struct XcdBarrier {
    unsigned* bar; unsigned x;
    volatile LAS unsigned* st;
};

__device__ __forceinline__ XcdBarrier xcd_barrier_post(unsigned* bar, volatile LAS unsigned* st) {
    XcdBarrier b; b.bar = bar; b.x = xb_xcc_id(); b.st = st;
    if (threadIdx.x == 0) (void)xb_add(&bar[XB_XCNT(b.x)], 1u);
    return b;
}
__device__ __forceinline__ void xcd_barrier_complete(unsigned* bar, unsigned x, unsigned& nloc, unsigned& nx) {
    const unsigned G = gridDim.x * gridDim.y * gridDim.z;
    unsigned sum, cnt, mine, sp = 0u;
    for (;;) {
        sum = 0u; cnt = 0u; mine = 0u;
#pragma unroll
        for (unsigned j = 0; j < 16; ++j) { const unsigned c = xb_ld(&bar[XB_XCNT(j)]); sum += c; cnt += (c > 0u) ? 1u : 0u; mine = (j == x) ? c : mine; }
        if (sum == G) break;
        __builtin_amdgcn_s_sleep(1);
        if ((++sp & 255u) == 0u) { if (xb_ld(&bar[XB_TMO])) break; if (sp > XB_SPIN_CAP) { atomicAdd(&bar[XB_TMO], 1u); break; } }
    }
    nloc = mine > 0u ? mine : 1u; nx = cnt > 0u ? cnt : 1u;
}

__device__ __forceinline__ void xcd_barrier(const XcdBarrier& b) {
    asm volatile("s_waitcnt vmcnt(0)" ::: "memory");
    __syncthreads();
    if (threadIdx.x == 0) {
        unsigned* bar = b.bar;
        __builtin_amdgcn_s_waitcnt(0);
        unsigned nloc = b.st[0], nx = b.st[1];
        if (nloc == 0u) { xcd_barrier_complete(bar, b.x, nloc, nx); b.st[0] = nloc; b.st[1] = nx; }
        const unsigned old = xb_add(&bar[XB_XSUB(b.x)], 1u);
        const unsigned gen = old / nloc;
        if (old + 1u == (gen + 1u) * nloc) {
            __builtin_amdgcn_fence(__ATOMIC_RELEASE, "agent");
            asm volatile("s_waitcnt vmcnt(0)" ::: "memory");
            const unsigned og = xb_add(&bar[XB_TOP], 1u);
            const unsigned tg = og / nx;
            if (og + 1u == (tg + 1u) * nx) xb_add(&bar[XB_TOPGEN], 1u);
            else XB_SPIN(xb_ld(&bar[XB_TOPGEN]) == tg, bar);
            __builtin_amdgcn_fence(__ATOMIC_ACQUIRE, "agent");
            xb_add(&bar[XB_XGEN(b.x)], 1u);
            asm volatile("s_waitcnt vmcnt(0)" ::: "memory");
        } else {
            XB_SPIN(xb_ld(&bar[XB_XGEN(b.x)]) == gen, bar);
            __builtin_amdgcn_fence(__ATOMIC_ACQUIRE, "agent");
            asm volatile("s_waitcnt vmcnt(0)" ::: "memory");
        }
    }
    __syncthreads();
}

__device__ __forceinline__ int fresh_tid() { int t = threadIdx.x; asm volatile("" : "+v"(t)); return t; }
__global__ void __launch_bounds__(NTHR, 2) mk_fwd(Args a) {
    extern __shared__ __attribute__((aligned(16))) unsigned char lds_raw[];
    LAS unsigned char* lds = (LAS unsigned char*)lds_raw;
    cg::grid_group grid = cg::this_grid();
    const int G = gridDim.x, bx = blockIdx.x;
    const int NGW = G * NWAVES, GT = G * NTHR;
    unsigned char* ws = a.ws;
    float* SS = (float*)(ws + WS_SS);
    float *ss0 = SS, *ss1 = SS + MTOK, *ss2 = SS + 2 * MTOK, *ss3 = SS + 3 * MTOK, *ss4 = SS + 4 * MTOK, *ssq = SS + 5 * MTOK, *sskv = SS + 6 * MTOK;
    unsigned* qctr = (unsigned*)(ws + WS_QCTR);
    const f32x2* rope = (const f32x2*)(ws + WS_ROPE);
    float* lf = (float*)(ws + WS_LF); float* cumf = (float*)(ws + WS_CUMF); const float* kmaxp = (const float*)(ws + WS_KMAX);
    bf16* XB = (bf16*)(ws + WS_XB);
    bf16* BIG = (bf16*)(ws + WS_BIG);
    bf16* QKV = BIG; bf16* O0 = (bf16*)(ws + WS_BIG + 192 * MiB);
    bf16* PROJ = BIG; bf16* QC = (bf16*)(ws + WS_BIG + 144 * MiB); bf16* KVC = (bf16*)(ws + WS_BIG + 192 * MiB); bf16* O1 = (bf16*)(ws + WS_BIG + 256 * MiB);
    bf16* YB = BIG;
    float* stash_gf = (float*)(ws + WS_BIG + 192 * MiB); float* stash_uf = stash_gf + (size_t)(MTOK / 64) * 2 * FF; float* stash_gl = stash_uf + (size_t)(MTOK / 64) * 2 * FF;
    using pg8::Gemm; using pg8::StaticOrder;

    { volatile LAS unsigned* misc0 = (volatile LAS unsigned*)(lds + RING_BYTES + 320); if (threadIdx.x < 32) misc0[threadIdx.x] = 0u; }
    __syncthreads();
    { const int tid = fresh_tid(), lane = tid & 63, wave = __builtin_amdgcn_readfirstlane(tid >> 6); p0_prologue(a, lds, bx * NWAVES + wave, NGW, lane, wave); }
    grid.sync();
    (void)xcd_barrier_post((unsigned*)(ws + WS_BAR), (volatile LAS unsigned*)(lds + RING_BYTES + 320) + 8);
#define XBAR() do { XcdBarrier xb_; xb_.bar = (unsigned*)(a.ws + WS_BAR); xb_.x = xb_xcc_id(); xb_.st = (volatile LAS unsigned*)(lds + RING_BYTES + 320) + 8; xcd_barrier(xb_); } while (0)


#ifndef SKIP_P1
    { Gemm g{XB, (const bf16*)(ws + WS_W_AB), MTOK, AB_COLS, DM, DM}; StaticOrder S; S.init(MTOK, AB_COLS, G, bx);
      pg8::EpiScaleBf16 E{QKV, AB_COLS, ss0, 1.0f / DM};
      pg8::gemm_phase<pg8::EpiScaleBf16, StaticOrder, true, true>(lds, g, S, E); }
#endif
    XBAR();

#ifndef SKIP_ATT0
    { att::Ptrs PA{QKV, AB_COLS, 64, QKV + 512, AB_COLS, 64, nullptr, 0, QKV + 1024, AB_COLS, 64, O0, 0, a.ab_rel_bias, nullptr};
      att::Ptrs PB{QKV + 1536, AB_COLS, 64, QKV + 2048, AB_COLS, 64, nullptr, 0, QKV + 2560, AB_COLS, 64, O0, 512, nullptr, nullptr};
      attn_phase<0>(PA, PB, qctr, lds); }
#endif
    XBAR();

#ifndef SKIP_P3
    { Gemm g{O0, (const bf16*)(ws + WS_W_OAB), MTOK, DM, DM, DM}; StaticOrder S; S.init(MTOK, DM, G, bx);
      pg8::EpiResid E{a.x, nullptr, nullptr, XB, ss1};
      pg8::gemm_phase<pg8::EpiResid, StaticOrder, true, true>(lds, g, S, E); }
#endif
    XBAR();
#pragma unroll 1
    for (int layer = 0; layer < 2; ++layer) {

#ifndef SKIP_GU
        { Gemm g{XB, (const bf16*)(ws + (layer ? WS_W_GU1 : WS_W_GU0)), MTOK, FF2, DM, DM}; StaticOrder S; S.init(MTOK, FF2, G, bx);
          pg8::EpiGU E{YB, layer ? ss3 : ss1, a.ffn_conv_w + (size_t)layer * 3 * FF, a.ffn_conv_b + (size_t)layer * FF, stash_gf, stash_uf, stash_gl};
          pg8::gemm_phase<pg8::EpiGU, StaticOrder, true, true>(lds, g, S, E); }
#endif
        XBAR();

#ifndef SKIP_ACT
        ffn_fixup(stash_gf, stash_uf, stash_gl, a.ffn_conv_w + (size_t)layer * 3 * FF, a.ffn_conv_b + (size_t)layer * FF, YB, bx * NTHR + fresh_tid(), GT);
#endif
        XBAR();

#ifndef SKIP_DN
        { Gemm g{YB, (const bf16*)(ws + (layer ? WS_W_DN1 : WS_W_DN0)), MTOK, DM, FF, FF}; StaticOrder S; S.init(MTOK, DM, G, bx);
          pg8::EpiResid E{nullptr, XB, nullptr, XB, layer ? ss4 : ss2};
          pg8::gemm_phase<pg8::EpiResid, StaticOrder, true, true>(lds, g, S, E); }
#endif
        XBAR();
        if (layer == 0) {

#ifndef SKIP_CD
            { Gemm g{XB, (const bf16*)(ws + WS_W_CD), MTOK, CD_PAD, DM, DM}; StaticOrder S; S.init(MTOK, CD_PAD, G, bx);
              pg8::EpiCD E{PROJ, ss2, ssq, sskv, lf, a.cd_b_f, (const pg8::f32x2*)rope};
              pg8::gemm_phase<pg8::EpiCD, StaticOrder, true, true>(lds, g, S, E); }
#endif
            XBAR();

#ifndef SKIP_P8
#ifndef SKIP_CUMF
            kmax_block(PROJ + 1184, (unsigned*)(ws + WS_KMAX), bx, fresh_tid());
            if (bx < 32) cumf_block(lf, cumf, bx, (LAS float*)lds, fresh_tid());
#endif
#ifndef SKIP_QUP
            { Gemm g{PROJ, (const bf16*)(ws + WS_W_UQ), MTOK, QC_COLS, Q_RANK, CD_PAD}; StaticOrder S; S.init(MTOK, QC_COLS, G, bx);
              pg8::EpiQ E{QC, ssq, (const pg8::f32x2*)rope};
              pg8::gemm_phase<pg8::EpiQ, StaticOrder, true, true>(lds, g, S, E); }
#endif
#ifndef SKIP_KVUP
            { Gemm g{PROJ + Q_RANK, (const bf16*)(ws + WS_W_UKV), MTOK, KVC_COLS, KV_RANK, CD_PAD}; StaticOrder S; S.init(MTOK, KVC_COLS, G, bx);
              pg8::EpiScaleBf16 E{KVC, KVC_COLS, sskv, 1.0f / KV_RANK};
              pg8::gemm_phase<pg8::EpiScaleBf16, StaticOrder, true, true>(lds, g, S, E); }
#endif
#endif
            XBAR();

#ifndef SKIP_ATT1
            { att::Ptrs PC{QC, QC_COLS, 96, KVC, KVC_COLS, 128, PROJ + 640, CD_PAD, KVC + 64, KVC_COLS, 128, O1, 0, nullptr, nullptr};
              att::Ptrs PD{PROJ + 672, CD_PAD, 64, PROJ + 1184, CD_PAD, 64, nullptr, 0, PROJ + 1696, CD_PAD, 64, O1, 512, cumf, kmaxp};
              attn_phase<1>(PC, PD, qctr + 8 * 64, lds); }
#endif
            XBAR();

#ifndef SKIP_P10
            { Gemm g{O1, (const bf16*)(ws + WS_W_OCD), MTOK, DM, DM, DM}; StaticOrder S; S.init(MTOK, DM, G, bx);
              pg8::EpiResid E{nullptr, XB, nullptr, XB, ss3};
              pg8::gemm_phase<pg8::EpiResid, StaticOrder, true, true>(lds, g, S, E); }
#endif
            XBAR();
        }
    }
    const int tidf = fresh_tid(), lane = tidf & 63, gw = bx * NWAVES + __builtin_amdgcn_readfirstlane(tidf >> 6);
    { const f32x4* gr = (const f32x4*)a.final_norm + lane; f32x4 gg[4];
#pragma unroll
      for (int j = 0; j < 4; ++j) gg[j] = gr[64 * j];
      for (int m0 = gw * 4; m0 < MTOK; m0 += NGW * 4) { unsigned long long v[4][4]; float rs[4];
#pragma unroll
          for (int r = 0; r < 4; ++r) { const unsigned long long* xr = (const unsigned long long*)(XB + (size_t)(m0 + r) * DM) + lane; rs[r] = rsqrtf(ss4[m0 + r] * (1.0f / DM) + RMS_EPS);
#pragma unroll
              for (int j = 0; j < 4; ++j) v[r][j] = xr[64 * j]; }
#pragma unroll
          for (int r = 0; r < 4; ++r) { f32x4* xw = (f32x4*)(a.out + (size_t)(m0 + r) * DM) + lane;
#pragma unroll
              for (int j = 0; j < 4; ++j) { const unsigned lo = (unsigned)v[r][j], hi = (unsigned)(v[r][j] >> 32); const f32x4 x4 = {bf_lo(lo), bf_hi(lo), bf_lo(hi), bf_hi(hi)};
                  __builtin_nontemporal_store(x4 * rs[r] * gg[j], xw + 64 * j); } } } }
}

extern "C" void kernel_launch(void* const* d_in, const int* in_sizes, int n_in, void* d_out, int out_size, void* d_ws, size_t ws_size, hipStream_t stream) {
    static int grid = 0;
    if (grid == 0) {
        if (n_in != 20 || in_sizes[0] != MTOK * DM || out_size != MTOK * DM || ws_size < WS_END) { fprintf(stderr, "kernel_launch: unexpected shapes / workspace (n_in %d, in0 %d, out %d, ws %zu, need %zu)\n", n_in, n_in > 0 ? in_sizes[0] : -1, out_size, ws_size, (size_t)WS_END); grid = -1; return; }
        int dev = 0, cus = 0, per_cu = 0;
        if (hipGetDevice(&dev) != hipSuccess || hipDeviceGetAttribute(&cus, hipDeviceAttributeMultiprocessorCount, dev) != hipSuccess) { grid = -1; return; }
        if (hipFuncSetAttribute((const void*)mk_fwd, hipFuncAttributeMaxDynamicSharedMemorySize, LDS_BYTES) != hipSuccess) { fprintf(stderr, "kernel_launch: hipFuncSetAttribute failed\n"); grid = -1; return; }
        if (hipOccupancyMaxActiveBlocksPerMultiprocessor(&per_cu, (const void*)mk_fwd, NTHR, LDS_BYTES) != hipSuccess || per_cu < 1) { fprintf(stderr, "kernel_launch: occupancy query says %d blocks per CU\n", per_cu); }
        (void)hipGetLastError();
        grid = cus;
    }
    if (grid < 0) return;
    Args a{};
    const float** p = (const float**)&a;
    for (int i = 0; i < 20; ++i) p[i] = (const float*)d_in[i];
    a.out = (float*)d_out; a.ws = (unsigned char*)d_ws;
    void* args[] = {&a};
    hipError_t e = hipLaunchCooperativeKernel((const void*)mk_fwd, dim3(grid), dim3(NTHR), args, LDS_BYTES, stream);
    if (e != hipSuccess) fprintf(stderr, "cooperative launch failed: %s (grid %d)\n", hipGetErrorString(e), grid);
}
```

```cpp
#include <hip/hip_runtime.h>
#include <hip/hip_cooperative_groups.h>
#include <cstdio>
#include <cstdint>
namespace cg = cooperative_groups;

constexpr int BATCH = 4, SEQ = 8192, DM = 1024, MTOK = BATCH * SEQ;
constexpr int AB_COLS = 3072, CD_COLS = 2216, CD_PAD = 2304, FF = 2816, FF2 = 2 * FF;
constexpr int Q_RANK = 384, KV_RANK = 256, QC_COLS = 768, KVC_COLS = 1024;
constexpr float RMS_EPS = 1e-6f, LOG2E = 1.4426950408889634f;
namespace pg8 {
#define PG8_LAS __attribute__((address_space(3)))
typedef unsigned short bf16_t;
typedef short bf16x8 __attribute__((ext_vector_type(8)));
typedef float f32x4 __attribute__((ext_vector_type(4)));
typedef unsigned u32x4 __attribute__((ext_vector_type(4)));
constexpr int BM = 256, BK = 64, HALF = 128, HTB = HALF * BK * 2  , STAGE_BYTES = 8 * HTB, NXCD = 8, WGM = 4;

__host__ __device__ __forceinline__ int lds_byte(int r, int c) { const int st = (r >> 4) * 2 + (c >> 5), rr = r & 15, cc = c & 31, ob = rr * 64 + cc * 2; return st * 1024 + (ob ^ (((ob >> 9) & 1) << 5)); }
__host__ __device__ __forceinline__ void stage_rc(int b, int& R, int& C) { const int st = b / 1024, sb = b % 1024, swz = sb ^ (((sb >> 9) & 1) << 5); R = (st >> 1) * 16 + swz / 64; C = (st & 1) * 32 + (swz % 64) / 2; }
__host__ __device__ __forceinline__ int perm32(int rho) { const int n = rho >> 4, i = rho & 15; return 8 * (i >> 2) + 4 * n + (i & 3); }

struct Unit { int pm, pn; };
struct Gemm { const bf16_t* A; const bf16_t* Bt; int M, N, K, lda; };

struct StaticOrder {
    int nM, nN, nwg, G, c;
    __host__ __device__ void init(int M, int N, int G_, int c_) { nM = M / BM; nN = N / BM; nwg = nM * nN; G = G_; c = c_; }
    __host__ __device__ bool next(int i, Unit& u) const {
        const long L = (long)i * G + c; if (L >= nwg) return false;
        int wgid = (int)L; { const int q = nwg / NXCD, r = nwg % NXCD, xcd = wgid % NXCD, off = wgid / NXCD; wgid = (xcd < r ? xcd * (q + 1) : r * (q + 1) + (xcd - r) * q) + off; }
        const int nig = WGM * nN, gid = wgid / nig, fm = gid * WGM, gsz = (nM - fm) < WGM ? (nM - fm) : WGM;
        u.pm = fm + ((wgid % nig) % gsz); u.pn = (wgid % nig) / gsz; return true;
    }
    __device__ __forceinline__ void a_ready(const Unit&) const {}
    __device__ __forceinline__ void done(const Unit&) const {}
};

__device__ __forceinline__ unsigned cvt_pk_bf16(float lo, float hi) { unsigned r; asm volatile("v_cvt_pk_bf16_f32 %0, %1, %2" : "=v"(r) : "v"(lo), "v"(hi)); return r; }
typedef unsigned u32x2 __attribute__((ext_vector_type(2)));
typedef float f32x2 __attribute__((ext_vector_type(2)));

struct EpiScaleBf16 {
    static constexpr bool PERM = true, AFTER_DRAIN = false;
    bf16_t* O; int ldc; const float* ss; float inv_n;
    __device__ __forceinline__ void operator()(const f32x4 (&acc)[2][2][4][2], const Unit& u, int wr, int wc, int fr, int fq) const {
        const int row0 = u.pm * BM + wr * 64 + fr; const int col0 = u.pn * BM + wc * 32 + 8 * fq;
#pragma unroll
        for (int ai = 0; ai < 2; ++ai)
#pragma unroll
            for (int m = 0; m < 4; ++m) { const int row = row0 + ai * HALF + m * 16; const float rs = rsqrtf(ss[row] * inv_n + RMS_EPS); bf16_t* rowp = O + (size_t)row * ldc + col0;
#pragma unroll
                for (int bj = 0; bj < 2; ++bj) { const f32x4 v0 = acc[ai][bj][m][0] * rs, v1 = acc[ai][bj][m][1] * rs;
                    u32x4 w; w.x = cvt_pk_bf16(v0[0], v0[1]); w.y = cvt_pk_bf16(v0[2], v0[3]); w.z = cvt_pk_bf16(v1[0], v1[1]); w.w = cvt_pk_bf16(v1[2], v1[3]);
                    *(u32x4*)(rowp + bj * HALF) = w; } }
    }
};

struct EpiResid {
    static constexpr bool PERM = false, AFTER_DRAIN = false;
    const float* base32; const bf16_t* base16; float* out; bf16_t* xb; float* ss;
    __device__ __forceinline__ void operator()(const f32x4 (&acc)[2][2][4][2], const Unit& u, int wr, int wc, int fr, int fq) const {
        const int col0 = u.pn * BM + wc * 32 + 4 * fq;
#pragma unroll
        for (int ai = 0; ai < 2; ++ai)
#pragma unroll
            for (int m = 0; m < 4; ++m) { const int row = u.pm * BM + ai * HALF + wr * 64 + m * 16 + fr; const size_t off = (size_t)row * DM + col0; float s = 0.f;
#pragma unroll
                for (int bj = 0; bj < 2; ++bj)
#pragma unroll
                    for (int n = 0; n < 2; ++n) { const size_t o2 = off + bj * HALF + n * 16; f32x4 bv;
                        if (base32) bv = *(const f32x4*)(base32 + o2);
                        else { const u32x2 bw = *(const u32x2*)(base16 + o2); bv[0] = __uint_as_float(bw.x << 16); bv[1] = __uint_as_float(bw.x & 0xffff0000u); bv[2] = __uint_as_float(bw.y << 16); bv[3] = __uint_as_float(bw.y & 0xffff0000u); }
                        const f32x4 v = bv + acc[ai][bj][m][n];
                        if (out) *(f32x4*)(out + o2) = v;
                        s += (v[0] * v[0] + v[1] * v[1]) + (v[2] * v[2] + v[3] * v[3]);
                        { u32x2 w; w.x = cvt_pk_bf16(v[0], v[1]); w.y = cvt_pk_bf16(v[2], v[3]); *(u32x2*)(xb + o2) = w; } }
                s += __shfl_xor(s, 16); s += __shfl_xor(s, 32);
                if (fq == 0) atomicAdd(ss + row, s);
                asm volatile("" ::: "memory"); }
    }
};

struct EpiCD {
    static constexpr bool PERM = false, AFTER_DRAIN = false;
    bf16_t* proj; const float* ss_in; float* ssq; float* sskv; float* lf; const float* b_f; const f32x2* rope;
    __device__ __forceinline__ void operator()(const f32x4 (&acc)[2][2][4][2], const Unit& u, int wr, int wc, int fr, int fq) const {
#pragma unroll
        for (int ai = 0; ai < 2; ++ai)
#pragma unroll
            for (int m = 0; m < 4; ++m) { const int row = u.pm * BM + ai * HALF + wr * 64 + m * 16 + fr; const float rs = rsqrtf(ss_in[row] * (1.0f / DM) + RMS_EPS); const int pos = row & (SEQ - 1);
#pragma unroll
                for (int bj = 0; bj < 2; ++bj) { const int cbase = u.pn * BM + bj * HALF + wc * 32;
                    f32x4 v0 = acc[ai][bj][m][0] * rs, v1 = acc[ai][bj][m][1] * rs;
                    if (cbase < Q_RANK + KV_RANK) {
                        float s = ((v0[0] * v0[0] + v0[1] * v0[1]) + (v0[2] * v0[2] + v0[3] * v0[3])) + ((v1[0] * v1[0] + v1[1] * v1[1]) + (v1[2] * v1[2] + v1[3] * v1[3]));
                        s += __shfl_xor(s, 16); s += __shfl_xor(s, 32);
                        if (fq == 0) atomicAdd((cbase < Q_RANK ? ssq : sskv) + row, s);
                    } else if (cbase == Q_RANK + KV_RANK) {
#pragma unroll
                        for (int e = 0; e < 4; ++e) { const f32x2 cs = rope[pos * 16 + 4 * fq + e]; const float x1 = v0[e], x2 = v1[e]; v0[e] = x1 * cs.x - x2 * cs.y; v1[e] = x2 * cs.x + x1 * cs.y; }
                    } else if (cbase == 2208) {
                        if (fq < 2) {
#pragma unroll
                            for (int e = 0; e < 4; ++e) { const int h = 4 * fq + e; const float z = v0[e] + b_f[h]; const float ls = -(fmaxf(-z, 0.f) + logf(1.0f + expf(-fabsf(z)))); lf[(size_t)row * 8 + h] = ls * LOG2E; }
                        }
                    }
                    if (cbase < 2208) { bf16_t* p = proj + (size_t)row * CD_PAD + cbase + 4 * fq;
                        u32x2 w0, w1; w0.x = cvt_pk_bf16(v0[0], v0[1]); w0.y = cvt_pk_bf16(v0[2], v0[3]); w1.x = cvt_pk_bf16(v1[0], v1[1]); w1.y = cvt_pk_bf16(v1[2], v1[3]);
                        *(u32x2*)p = w0; *(u32x2*)(p + 16) = w1; } }
                asm volatile("" ::: "memory"); }
    }
};

struct EpiQ {
    static constexpr bool PERM = false, AFTER_DRAIN = false;
    bf16_t* qc; const float* ssq; const f32x2* rope;
    __device__ __forceinline__ void operator()(const f32x4 (&acc)[2][2][4][2], const Unit& u, int wr, int wc, int fr, int fq) const {
#pragma unroll
        for (int ai = 0; ai < 2; ++ai)
#pragma unroll
            for (int m = 0; m < 4; ++m) { const int row = u.pm * BM + ai * HALF + wr * 64 + m * 16 + fr; const float rs = rsqrtf(ssq[row] * (1.0f / Q_RANK) + RMS_EPS); const int pos = row & (SEQ - 1);
#pragma unroll
                for (int bj = 0; bj < 2; ++bj) { const int cbase = u.pn * BM + bj * HALF + wc * 32;
                    f32x4 v0 = acc[ai][bj][m][0] * rs, v1 = acc[ai][bj][m][1] * rs;
                    if (((cbase >> 5) % 3) == 2) {
#pragma unroll
                        for (int e = 0; e < 4; ++e) { const f32x2 cs = rope[pos * 16 + 4 * fq + e]; const float x1 = v0[e], x2 = v1[e]; v0[e] = x1 * cs.x - x2 * cs.y; v1[e] = x2 * cs.x + x1 * cs.y; }
                    }
                    bf16_t* p = qc + (size_t)row * QC_COLS + cbase + 4 * fq;
                    u32x2 w0, w1; w0.x = cvt_pk_bf16(v0[0], v0[1]); w0.y = cvt_pk_bf16(v0[2], v0[3]); w1.x = cvt_pk_bf16(v1[0], v1[1]); w1.y = cvt_pk_bf16(v1[2], v1[3]);
                    *(u32x2*)p = w0; *(u32x2*)(p + 16) = w1; }
                asm volatile("" ::: "memory"); }
    }
};

template <int CTRL> __device__ __forceinline__ float dpp_row_ror(float v) { return __int_as_float(__builtin_amdgcn_update_dpp(0, __float_as_int(v), CTRL, 0xF, 0xF, false)); }
struct EpiGU {
    static constexpr bool PERM = false, AFTER_DRAIN = false;
    bf16_t* Y; const float* ss; const float* cw; const float* cb; float* gf; float* uf; float* gl;
    __device__ __forceinline__ void operator()(const f32x4 (&acc)[2][2][4][2], const Unit& u, int wr, int wc, int fr, int fq) const {
#pragma unroll
        for (int ai = 0; ai < 2; ++ai) {
            const int grp = u.pm * 4 + ai * 2 + wr, rowg = grp * 64;
            float rs[4];
#pragma unroll
            for (int m = 0; m < 4; ++m) rs[m] = rsqrtf(ss[rowg + 16 * m + fr] * (1.0f / DM) + RMS_EPS);
#pragma unroll
            for (int n = 0; n < 2; ++n) {
                const int c = u.pn * HALF + wc * 32 + n * 16 + 4 * fq;
                const f32x4 w0 = *(const f32x4*)(cw + c), w1 = *(const f32x4*)(cw + FF + c), w2 = *(const f32x4*)(cw + 2 * FF + c), bb = *(const f32x4*)(cb + c);
                f32x4 pr1 = {0.f, 0.f, 0.f, 0.f}, pr2 = {0.f, 0.f, 0.f, 0.f};
#pragma unroll
                for (int m = 0; m < 4; ++m) {
                    const f32x4 g0 = acc[ai][0][m][n] * rs[m], u0 = acc[ai][1][m][n] * rs[m];
                    f32x4 r1, r2;
#pragma unroll
                    for (int e2 = 0; e2 < 4; ++e2) { r1[e2] = dpp_row_ror<0x121>(g0[e2]); r2[e2] = dpp_row_ror<0x122>(g0[e2]); }
                    const f32x4 g1 = (fr >= 1) ? r1 : pr1, g2 = (fr >= 2) ? r2 : pr2;
                    pr1 = r1; pr2 = r2;
                    const f32x4 xg = w0 * g2 + w1 * g1 + w2 * g0 + bb; f32x4 y;
#pragma unroll
                    for (int e2 = 0; e2 < 4; ++e2) y[e2] = xg[e2] * __builtin_amdgcn_rcpf(1.0f + __expf(-xg[e2])) * u0[e2];
                    const int row = rowg + 16 * m + fr;
                    if (m > 0 || fr >= 2) { u32x2 w; w.x = cvt_pk_bf16(y[0], y[1]); w.y = cvt_pk_bf16(y[2], y[3]); *(u32x2*)(Y + (size_t)row * FF + c) = w; }
                    if (m == 0) { if (fr < 2) { *(f32x4*)(gf + (size_t)(grp * 2 + fr) * FF + c) = g0; *(f32x4*)(uf + (size_t)(grp * 2 + fr) * FF + c) = u0; } }
                    if (m == 3) { if (fr >= 14) *(f32x4*)(gl + (size_t)(grp * 2 + fr - 14) * FF + c) = g0; }
                }
            }
            asm volatile("" ::: "memory");
        }
    }
};

template <class Epi, class Sched, bool ALIGN_EPI = false, bool SP2 = false>
__device__ __forceinline__ void gemm_phase(PG8_LAS unsigned char* lds, const Gemm g, const Sched& S, const Epi& E) {
    int tid_ = threadIdx.x; asm volatile("" : "+v"(tid_)); const int tid = tid_, wid = __builtin_amdgcn_readfirstlane(tid >> 6), lane = tid & 63, wr = wid >> 2, wc = wid & 3, fr = lane & 15, fq = lane >> 4;
    int K_ = g.K; asm volatile("" : "+s"(K_)); const int K = K_, nt = K / BK;
    unsigned voffA[2], voffB[2];
#pragma unroll
    for (int i = 0; i < 2; ++i) { int R, C; stage_rc(tid * 16 + i * 8192, R, C); const int Rb = Epi::PERM ? ((R & ~31) + perm32(R & 31)) : R;
        voffA[i] = (unsigned)(R * g.lda + C) * 2u; voffB[i] = (unsigned)(Rb * K + C) * 2u; }
    const size_t kstep = (size_t)(BK * 2);
    const size_t hstepB = (size_t)HALF * K * 2, hstepA = (size_t)HALF * g.lda * 2;
    const size_t tstepA = 2 * hstepA, tstepB = 2 * hstepB;
    const unsigned ldsw = (unsigned)wid * 1024u;
    const int aoff = lds_byte(wr * 64 + fr, fq * 8), boff = lds_byte(wc * 32 + fr, fq * 8);
#define PG8_SA(b, h) (((b) * 2 + (h)) * HTB)
#define PG8_SB(b, h) ((4 + (b) * 2 + (h)) * HTB)
#define PG8_STAGE(bufoff, gbase, voff) do { _Pragma("unroll") for (int _i = 0; _i < 2; ++_i) \
        __builtin_amdgcn_global_load_lds((const unsigned*)((const char*)(gbase) + (voff)[_i]), (PG8_LAS unsigned*)(lds + (bufoff) + ldsw + _i * 8192), 16, 0, 0); } while (0)
#define PG8_LDA(dst, b, h) do { _Pragma("unroll") for (int m = 0; m < 4; ++m) _Pragma("unroll") for (int k = 0; k < 2; ++k) dst[m][k] = *(const PG8_LAS bf16x8*)(lds + PG8_SA(b, h) + aoff + m * 2048 + k * 1024); } while (0)
#define PG8_LDB(dst, b, h) do { _Pragma("unroll") for (int n = 0; n < 2; ++n) _Pragma("unroll") for (int k = 0; k < 2; ++k) dst[n][k] = *(const PG8_LAS bf16x8*)(lds + PG8_SB(b, h) + boff + n * 2048 + k * 1024); } while (0)
#define PG8_MMA(ai, bj, At, Bt) do { __builtin_amdgcn_s_setprio(1); _Pragma("unroll") for (int m = 0; m < 4; ++m) _Pragma("unroll") for (int n = 0; n < 2; ++n) _Pragma("unroll") for (int k = 0; k < 2; ++k) \
        acc[ai][bj][m][n] = __builtin_amdgcn_mfma_f32_16x16x32_bf16(Bt[n][k], At[m][k], acc[ai][bj][m][n], 0, 0, 0); __builtin_amdgcn_s_setprio(0); } while (0)
#define PG8_WAIT_V(n) asm volatile("s_waitcnt vmcnt(" #n ")" ::: "memory")
#define PG8_WAIT_L(n) asm volatile("s_waitcnt lgkmcnt(" #n ")" ::: "memory")
#define PG8_BAR __builtin_amdgcn_s_barrier()
#define PG8_SCHED __builtin_amdgcn_sched_barrier(0)
    Unit cur, nxt; int ui = 0;
    if (!S.next(0, cur)) return;
    f32x4 acc[2][2][4][2];
#pragma unroll
    for (int a = 0; a < 2; ++a)
#pragma unroll
        for (int b = 0; b < 2; ++b)
#pragma unroll
            for (int m = 0; m < 4; ++m)
#pragma unroll
                for (int n = 0; n < 2; ++n) acc[a][b][m][n] = (f32x4){0.f, 0.f, 0.f, 0.f};
    bf16x8 At[4][2], B0[2][2], B1[2][2];
    const char* cA = (const char*)g.A + (size_t)cur.pm * tstepA; const char* cB = (const char*)g.Bt + (size_t)cur.pn * tstepB;
    S.a_ready(cur);
    if constexpr (SP2) {
        PG8_STAGE(PG8_SB(0, 0), cB, voffB); PG8_STAGE(PG8_SB(0, 1), cB + hstepB, voffB); PG8_STAGE(PG8_SA(0, 0), cA, voffA); PG8_STAGE(PG8_SA(0, 1), cA + hstepA, voffA);
        if (wr == 1) PG8_BAR;
        PG8_WAIT_V(2); PG8_BAR;
        PG8_STAGE(PG8_SB(1, 0), cB + kstep, voffB); PG8_STAGE(PG8_SA(1, 0), cA + kstep, voffA); PG8_STAGE(PG8_SB(1, 1), cB + hstepB + kstep, voffB);
        PG8_WAIT_V(6); PG8_BAR;
    } else {
        PG8_STAGE(PG8_SB(0, 0), cB, voffB); PG8_STAGE(PG8_SA(0, 0), cA, voffA); PG8_STAGE(PG8_SB(0, 1), cB + hstepB, voffB); PG8_STAGE(PG8_SA(0, 1), cA + hstepA, voffA);
        if (wr == 1) PG8_BAR;
        PG8_WAIT_V(4); PG8_BAR;
        PG8_STAGE(PG8_SB(1, 0), cB + kstep, voffB); PG8_STAGE(PG8_SA(1, 0), cA + kstep, voffA); PG8_STAGE(PG8_SB(1, 1), cB + hstepB + kstep, voffB);
        PG8_WAIT_V(6); PG8_BAR;
    }
    for (;;) {
        const bool has_next = S.next(ui + 1, nxt);
        const char* nA = has_next ? (const char*)g.A + (size_t)nxt.pm * tstepA : cA; const char* nB = has_next ? (const char*)g.Bt + (size_t)nxt.pn * tstepB : cB;
        for (int t = 0; t < nt; t += 2) {
            const bool last = (t == nt - 2);
            const char* a1 = cA + (size_t)(t + 1) * kstep;
            const char* a2 = last ? nA : cA + (size_t)(t + 2) * kstep; const char* b2 = last ? nB : cB + (size_t)(t + 2) * kstep;
            const char* a3 = a2 + kstep; const char* b3 = b2 + kstep;
            if (last && has_next) S.a_ready(nxt);
            if constexpr (SP2) {
            PG8_LDB(B0, 0, 0); PG8_LDB(B1, 0, 1); PG8_SCHED; PG8_LDA(At, 0, 0); PG8_STAGE(PG8_SA(1, 1), a1 + hstepA, voffA);
            PG8_WAIT_V(8); PG8_WAIT_L(0); PG8_BAR; PG8_MMA(0, 0, At, B0); PG8_MMA(0, 1, At, B1); PG8_BAR; PG8_SCHED;
            PG8_LDA(At, 0, 1); PG8_STAGE(PG8_SB(0, 0), b2, voffB); PG8_STAGE(PG8_SB(0, 1), b2 + hstepB, voffB); PG8_STAGE(PG8_SA(0, 0), a2, voffA);
            PG8_WAIT_V(8); PG8_WAIT_L(0); PG8_BAR; PG8_MMA(1, 0, At, B0); PG8_MMA(1, 1, At, B1); PG8_BAR; PG8_SCHED;
            PG8_LDB(B0, 1, 0); PG8_LDB(B1, 1, 1); PG8_SCHED; PG8_LDA(At, 1, 0); PG8_STAGE(PG8_SA(0, 1), a2 + hstepA, voffA);
            PG8_WAIT_V(8); PG8_WAIT_L(0); PG8_BAR; PG8_MMA(0, 0, At, B0); PG8_MMA(0, 1, At, B1); PG8_BAR; PG8_SCHED;
            PG8_LDA(At, 1, 1); PG8_STAGE(PG8_SB(1, 0), b3, voffB); PG8_STAGE(PG8_SB(1, 1), b3 + hstepB, voffB); PG8_STAGE(PG8_SA(1, 0), a3, voffA);
            PG8_WAIT_V(8); PG8_WAIT_L(0); PG8_BAR; PG8_MMA(1, 0, At, B0); PG8_MMA(1, 1, At, B1); PG8_BAR; PG8_SCHED;
            } else {
            PG8_LDB(B0, 0, 0); PG8_SCHED; PG8_LDA(At, 0, 0); PG8_STAGE(PG8_SA(1, 1), a1 + hstepA, voffA);
            PG8_WAIT_L(8); PG8_BAR; PG8_WAIT_L(0); PG8_MMA(0, 0, At, B0); PG8_BAR; PG8_SCHED;
            PG8_LDB(B1, 0, 1); PG8_STAGE(PG8_SB(0, 0), b2, voffB);
            PG8_BAR; PG8_WAIT_L(0); PG8_MMA(0, 1, At, B1); PG8_BAR;
            PG8_LDA(At, 0, 1); PG8_STAGE(PG8_SA(0, 0), a2, voffA);
            PG8_BAR; PG8_WAIT_L(0); PG8_MMA(1, 0, At, B0); PG8_BAR; PG8_SCHED;
            PG8_STAGE(PG8_SB(0, 1), b2 + hstepB, voffB);
            PG8_WAIT_V(6); PG8_BAR; PG8_MMA(1, 1, At, B1); PG8_BAR;
            PG8_LDB(B0, 1, 0); PG8_SCHED; PG8_LDA(At, 1, 0); PG8_STAGE(PG8_SA(0, 1), a2 + hstepA, voffA);
            PG8_WAIT_L(8); PG8_BAR; PG8_WAIT_L(0); PG8_MMA(0, 0, At, B0); PG8_BAR; PG8_SCHED;
            PG8_LDB(B1, 1, 1); PG8_STAGE(PG8_SB(1, 0), b3, voffB);
            PG8_BAR; PG8_WAIT_L(0); PG8_MMA(0, 1, At, B1); PG8_BAR;
            PG8_LDA(At, 1, 1); PG8_STAGE(PG8_SA(1, 0), a3, voffA);
            PG8_BAR; PG8_WAIT_L(0); PG8_MMA(1, 0, At, B0); PG8_BAR; PG8_SCHED;
            PG8_STAGE(PG8_SB(1, 1), b3 + hstepB, voffB);
            PG8_WAIT_V(6); PG8_BAR; PG8_MMA(1, 1, At, B1); PG8_BAR;
            }
        }
        if constexpr (ALIGN_EPI) { if (wr == 0) PG8_BAR; }
        if constexpr (!Epi::AFTER_DRAIN) { E(acc, cur, wr, wc, fr, fq); S.done(cur); }
        if (!has_next) break;
#pragma unroll
        for (int a = 0; a < 2; ++a)
#pragma unroll
            for (int b = 0; b < 2; ++b)
#pragma unroll
                for (int m = 0; m < 4; ++m)
#pragma unroll
                    for (int n = 0; n < 2; ++n) acc[a][b][m][n] = (f32x4){0.f, 0.f, 0.f, 0.f};
        cur = nxt; cA = nA; cB = nB; ++ui;
        if constexpr (ALIGN_EPI) { if (wr == 1) PG8_BAR; }
    }
    PG8_WAIT_V(0);
    if constexpr (!ALIGN_EPI) { if (wr == 0) PG8_BAR; }
    PG8_BAR;
    if constexpr (Epi::AFTER_DRAIN) { E.fused(acc, cur, wr, wc, fr, fq, lds, wid, lane); S.done(cur); }
#undef PG8_SA
#undef PG8_SB
#undef PG8_STAGE
#undef PG8_LDA
#undef PG8_LDB
#undef PG8_MMA
#undef PG8_WAIT_V
#undef PG8_WAIT_L
#undef PG8_BAR
#undef PG8_SCHED
}
}
namespace att {
#define LAS3 __attribute__((address_space(3)))
typedef unsigned short bf16_t;
typedef short bf16x8 __attribute__((ext_vector_type(8)));
typedef short s16x4 __attribute__((ext_vector_type(4)));
typedef float f32x16 __attribute__((ext_vector_type(16)));
typedef float f32x4 __attribute__((ext_vector_type(4)));
typedef unsigned u32x4 __attribute__((ext_vector_type(4)));
typedef unsigned u32x2 __attribute__((ext_vector_type(2)));
constexpr int KBUF = 13312, VBUF = 8192, FBUF = 256, BUFB = KBUF + VBUF + FBUF;
constexpr int TB_OFF = 4 * BUFB, QIDX_OFF = TB_OFF + 1040, FLAG_OFF = QIDX_OFF + 16, ATT_LDS = FLAG_OFF + 16;
constexpr float NEG_BIG = -1.0e30f;

typedef float f32x2_t __attribute__((ext_vector_type(2))); typedef __bf16 bf16x2_t __attribute__((ext_vector_type(2)));
__device__ __forceinline__ unsigned pk2(float lo, float hi) { f32x2_t v = {lo, hi}; bf16x2_t b = __builtin_convertvector(v, bf16x2_t); return __builtin_bit_cast(unsigned, b); }
__device__ __forceinline__ float lane32_other(float v) {
    auto rr = __builtin_amdgcn_permlane32_swap(__float_as_uint(v), __float_as_uint(v), false, false);
    return (__lane_id() & 32) ? __uint_as_float(rr[0]) : __uint_as_float(rr[1]);
}
__device__ __forceinline__ float lane32_max(float v) { auto rr = __builtin_amdgcn_permlane32_swap(__float_as_uint(v), __float_as_uint(v), false, false); return fmaxf(__uint_as_float(rr[0]), __uint_as_float(rr[1])); }
__device__ __forceinline__ float lane32_sum(float v) { auto rr = __builtin_amdgcn_permlane32_swap(__float_as_uint(v), __float_as_uint(v), false, false); return __uint_as_float(rr[0]) + __uint_as_float(rr[1]); }
__device__ __forceinline__ s16x4 vtr(const LAS3 unsigned char* p) { typedef short v4i16_t __attribute__((ext_vector_type(4))); return __builtin_bit_cast(s16x4, __builtin_amdgcn_ds_read_tr16_b64_v4i16((LAS3 v4i16_t*)p)); }

struct Ptrs {
    const bf16_t* Q; int qp, qh;
    const bf16_t* K; int kp, kh;
    const bf16_t* K2; int k2p;
    const bf16_t* V; int vp, vh;
    bf16_t* O; int oc;
    const float* bias;
    const float* kmax;
};

template <int VAR>
__device__ __forceinline__ void attn_unit(const Ptrs& P, int b, int h, int qb, LAS3 unsigned char* lds) {
    constexpr int DQ = (VAR == 2) ? 96 : 64, ND = DQ / 16, KP = DQ * 2 + 16;
    constexpr bool DESC = (VAR == 1 || VAR == 3);
    int tid_ = threadIdx.x; asm volatile("" : "+v"(tid_)); const int tid = tid_, lane = tid & 63, r32 = lane & 31, hi = lane >> 5; const int wid = __builtin_amdgcn_readfirstlane(tid >> 6);
    const size_t rowbase = (size_t)b * SEQ; const int q0 = qb * 256, qrow = q0 + wid * 32 + r32;
    const int cw = 4 * qb + (wid >> 1);
    const int t_hi = 4 * qb + 3, t_lo = (VAR == 0) ? ((4 * qb - 8) > 0 ? (4 * qb - 8) : 0) : 0, nt = t_hi - t_lo + 1;
    const int w_lo = (VAR == 0) ? ((cw - 8) > 0 ? (cw - 8) : 0) : 0, w_hi = cw;
    LAS3 float* TB = (LAS3 float*)(lds + TB_OFF);
    if (VAR == 0) { for (int i = tid; i < 257; i += 512) TB[i] = P.bias[h * 257 + i] * LOG2E; }
    volatile LAS3 unsigned* donec = (volatile LAS3 unsigned*)(lds + FLAG_OFF);
    bool wdone = false; int dp = 0;
    if (DESC) { if (tid == 0) donec[0] = 0u; }
    bf16x8 qf[ND];
    { const bf16_t* qp = P.Q + (rowbase + qrow) * P.qp + h * P.qh + hi * 8;
#pragma unroll
      for (int d0 = 0; d0 < ND; ++d0) qf[d0] = *(const bf16x8*)(qp + d0 * 16); }
    float qk_bound = 0.f;
    if (VAR == 3) { float s2_ = 0.f;
#pragma unroll
        for (int d0 = 0; d0 < ND; ++d0)
#pragma unroll
            for (int e = 0; e < 8; ++e) { const float v_ = __uint_as_float(((unsigned)(unsigned short)qf[d0][e]) << 16); s2_ += v_ * v_; }
        s2_ = lane32_sum(s2_); qk_bound = sqrtf(s2_) * P.kmax[b * 8 + h] * 1.001f; }
    const int lkey = tid >> 3, lj = tid & 7;
    const bf16_t* kg = P.K + (rowbase + lkey) * P.kp + h * P.kh + lj * 8;
    const bf16_t* vg = P.V + (rowbase + lkey) * P.vp + h * P.vh + lj * 8;
    const bf16_t* k2g = (VAR == 2) ? P.K2 + (rowbase + (tid >> 2)) * P.k2p + (tid & 3) * 8 : nullptr;
    const float* fg = (VAR == 3) ? P.bias + ((size_t)(b * 8 + h)) * SEQ + (tid & 15) * 4 : nullptr;
    const int kw = lkey * KP + lj * 16, vw = KBUF + (lj >> 2) * 4096 + lkey * 64 + (lj & 3) * 16, k2w = (tid >> 2) * KP + 128 + (tid & 3) * 16, fw = KBUF + VBUF + (tid & 15) * 16;
    u32x4 rkA, rvA, rk2A, rkB, rvB, rk2B; f32x4 rfA, rfB;
#define ATT_LOAD(t, S) do { const size_t ko_ = (size_t)(t) * 64; rk##S = *(const u32x4*)(kg + ko_ * P.kp); rv##S = *(const u32x4*)(vg + ko_ * P.vp); \
        if (VAR == 2) { if (tid < 256) rk2##S = *(const u32x4*)(k2g + ko_ * P.k2p); } if (VAR == 3) { if (tid < 16) rf##S = *(const f32x4*)(fg + ko_); } } while (0)
#define ATT_STORE(bufo, S) do { *(LAS3 u32x4*)(lds + (bufo) + kw) = rk##S; *(LAS3 u32x4*)(lds + (bufo) + vw) = rv##S; \
        if (VAR == 2) { if (tid < 256) *(LAS3 u32x4*)(lds + (bufo) + k2w) = rk2##S; } if (VAR == 3) { if (tid < 16) *(LAS3 f32x4*)(lds + (bufo) + fw) = rf##S; } } while (0)
    const int pi = (r32 & ~12) | ((r32 & 4) << 1) | ((r32 & 8) >> 1);
    const int ka = pi * KP + hi * 16;
    const int va = KBUF + (8 * hi + ((lane & 15) >> 2)) * 64 + (16 * ((lane >> 4) & 1) + 4 * (lane & 3)) * 2;
    float m_run = NEG_BIG, l_run = 0.f, R = 0.f;
    f32x16 ot0 = {}, ot1 = {};
    { const int t0 = DESC ? t_hi : t_lo, t1 = DESC ? (t_hi - 1) : (t_lo + 1); ATT_LOAD(t0, A); ATT_LOAD(t1, B); ATT_STORE(0, A); ATT_STORE(BUFB, B); }
    __syncthreads();
    const int np = nt >> 1;
    for (int ip = 0; ip < np; ++ip) {
        const int pbase = (ip & 1) * 2 * BUFB, npbase = 2 * BUFB - pbase;
        const bool more = (ip + 1 < np);
        if (more) { const int ta = DESC ? (t_hi - 2 * ip - 2) : (t_lo + 2 * ip + 2), tb = DESC ? (ta - 1) : (ta + 1); ATT_LOAD(ta, A); ATT_LOAD(tb, B); }
        if (DESC) { if (tid == 0) donec[dp == 2 ? 0 : dp + 1] = 0u; }
#pragma unroll
        for (int sub = 0; sub < 2; ++sub) {
        const int it = 2 * ip + sub;
        const int t = DESC ? (t_hi - it) : (t_lo + it);
        const int bufo = pbase + sub * BUFB;
        if (t >= w_lo && t <= w_hi && !(DESC && wdone)) {
            f32x16 sa = {}, sb = {};
            const LAS3 unsigned char* kb = lds + bufo + ka;
#pragma unroll
            for (int d0 = 0; d0 < ND; ++d0) {
                const bf16x8 k0 = *(const LAS3 bf16x8*)(kb + d0 * 32), k1 = *(const LAS3 bf16x8*)(kb + 32 * KP + d0 * 32);
                sa = __builtin_amdgcn_mfma_f32_32x32x16_bf16(k0, qf[d0], sa, 0, 0, 0);
                sb = __builtin_amdgcn_mfma_f32_32x32x16_bf16(k1, qf[d0], sb, 0, 0, 0);
            }
            bf16x8 pk[4];
            if (VAR != 1) {
                if (VAR == 0) {
                    if (cw - t >= 3) { const float c = TB[256];
#pragma unroll
                        for (int r = 0; r < 16; ++r) { sa[r] += c; sb[r] += c; } }
                    else { const int d0_ = qrow - 64 * t - 8 * hi + 128;
#pragma unroll
                        for (int r = 0; r < 16; ++r) { int ia = d0_ - 16 * (r >> 3) - (r & 7), ib = ia - 32; ia = ia < 0 ? 0 : (ia > 256 ? 256 : ia); ib = ib < 0 ? 0 : (ib > 256 ? 256 : ib);
                            sa[r] += TB[ia]; sb[r] += TB[ib]; } }
                }
                if (VAR == 3) {
                    const LAS3 float* F = (const LAS3 float*)(lds + bufo + KBUF + VBUF) + 8 * hi;
#pragma unroll
                    for (int a = 0; a < 2; ++a) {
                        const f32x4 fa0 = *(const LAS3 f32x4*)(F + 16 * a), fa1 = *(const LAS3 f32x4*)(F + 16 * a + 4), fb0 = *(const LAS3 f32x4*)(F + 32 + 16 * a), fb1 = *(const LAS3 f32x4*)(F + 32 + 16 * a + 4);
#pragma unroll
                        for (int e = 0; e < 4; ++e) { sa[8 * a + e] -= fa0[e]; sa[8 * a + 4 + e] -= fa1[e]; sb[8 * a + e] -= fb0[e]; sb[8 * a + 4 + e] -= fb1[e]; }
                    }
                    if (t == cw) { const int lim = qrow - 64 * t - 8 * hi;
#pragma unroll
                        for (int r = 0; r < 16; ++r) { const int kk = 16 * (r >> 3) + (r & 7); if (kk > lim) sa[r] = NEG_BIG; if (kk + 32 > lim) sb[r] = NEG_BIG; } }
                }
                float mx = fmaxf(sa[0], sb[0]);
#pragma unroll
                for (int r = 1; r < 16; ++r) mx = fmaxf(mx, fmaxf(sa[r], sb[r]));
                mx = lane32_max(mx);
                const float m_new = fmaxf(m_run, mx), alpha = __builtin_amdgcn_exp2f(m_run - m_new); m_run = m_new;
                float ls = 0.f;
#pragma unroll
                for (int r = 0; r < 16; ++r) { sa[r] = __builtin_amdgcn_exp2f(sa[r] - m_new); sb[r] = __builtin_amdgcn_exp2f(sb[r] - m_new); ls += sa[r] + sb[r]; }
                l_run = l_run * alpha + ls;
#pragma unroll
                for (int r = 0; r < 16; ++r) { ot0[r] *= alpha; ot1[r] *= alpha; }
                if (VAR == 3) {
                    const float f0_ = *((const LAS3 float*)(lds + bufo + KBUF + VBUF));
                    if (__all(qk_bound - f0_ - m_run < -160.0f) || t == 0) wdone = true;
                }
            } else {
                const int lim = (t == cw) ? (qrow - 64 * t - 8 * hi) : 1000;
                float seg[4];
#pragma unroll
                for (int a = 0; a < 4; ++a) { float run = 0.f;
#pragma unroll
                    for (int j = 7; j >= 0; --j) { const int r = 8 * (a & 1) + j; const float z = (a < 2) ? sa[r] : sb[r]; const int kk = 16 * a + j;
                        const float sp = fmaxf(z, 0.f) + __logf(1.0f + __expf(-fabsf(z)));
                        const bool vis = kk < lim;
                        const float lb = z - sp + run;
                        if (a < 2) sa[r] = vis ? lb : NEG_BIG; else sb[r] = vis ? lb : NEG_BIG;
                        run += vis ? -sp : 0.f; }
                    seg[a] = run; }
                float oth[4];
#pragma unroll
                for (int a = 0; a < 4; ++a) oth[a] = lane32_other(seg[a]);
                float off[4]; float accu = R;
#pragma unroll
                for (int a = 3; a >= 0; --a) { if (hi) { off[a] = accu; accu += seg[a] + oth[a]; } else { off[a] = accu + oth[a]; accu += seg[a] + oth[a]; } }
                R = accu;
                if (__all(R < -105.0f) || t == 0) wdone = true;
#pragma unroll
                for (int r = 0; r < 8; ++r) { sa[r] = __expf(sa[r] + off[0]); sa[8 + r] = __expf(sa[8 + r] + off[1]); sb[r] = __expf(sb[r] + off[2]); sb[8 + r] = __expf(sb[8 + r] + off[3]); }
            }
            { u32x4 w;
              w.x = pk2(sa[0], sa[1]); w.y = pk2(sa[2], sa[3]); w.z = pk2(sa[4], sa[5]); w.w = pk2(sa[6], sa[7]); pk[0] = __builtin_bit_cast(bf16x8, w);
              w.x = pk2(sa[8], sa[9]); w.y = pk2(sa[10], sa[11]); w.z = pk2(sa[12], sa[13]); w.w = pk2(sa[14], sa[15]); pk[1] = __builtin_bit_cast(bf16x8, w);
              w.x = pk2(sb[0], sb[1]); w.y = pk2(sb[2], sb[3]); w.z = pk2(sb[4], sb[5]); w.w = pk2(sb[6], sb[7]); pk[2] = __builtin_bit_cast(bf16x8, w);
              w.x = pk2(sb[8], sb[9]); w.y = pk2(sb[10], sb[11]); w.z = pk2(sb[12], sb[13]); w.w = pk2(sb[14], sb[15]); pk[3] = __builtin_bit_cast(bf16x8, w); }
            const LAS3 unsigned char* vb = lds + bufo + va;
#pragma unroll
            for (int s = 0; s < 4; ++s) {
                const s16x4 a0 = vtr(vb + s * 1024), a1 = vtr(vb + s * 1024 + 256), c0 = vtr(vb + 4096 + s * 1024), c1 = vtr(vb + 4096 + s * 1024 + 256);
                const bf16x8 v0 = {a0[0], a0[1], a0[2], a0[3], a1[0], a1[1], a1[2], a1[3]}, v1 = {c0[0], c0[1], c0[2], c0[3], c1[0], c1[1], c1[2], c1[3]};
                ot0 = __builtin_amdgcn_mfma_f32_32x32x16_bf16(v0, pk[s], ot0, 0, 0, 0);
                ot1 = __builtin_amdgcn_mfma_f32_32x32x16_bf16(v1, pk[s], ot1, 0, 0, 0);
            }
        }
        }
        if (more) { ATT_STORE(npbase, A); ATT_STORE(npbase + BUFB, B); }
        if (DESC) { if (wdone && lane == 0) __hip_atomic_fetch_add((LAS3 unsigned*)(lds + FLAG_OFF) + dp, 1u, __ATOMIC_RELAXED, __HIP_MEMORY_SCOPE_WORKGROUP); }
        __syncthreads();
        if (DESC) { if (donec[dp] == 8u) break; dp = (dp == 2) ? 0 : dp + 1; }
    }
#undef ATT_LOAD
#undef ATT_STORE
    float inv = 1.f;
    if (VAR != 1) { const float lt = lane32_sum(l_run); inv = 1.0f / lt; }
    bf16_t* op = P.O + (rowbase + qrow) * DM + P.oc + h * 64 + 4 * hi;
#pragma unroll
    for (int a = 0; a < 4; ++a) {
        u32x2 w0, w1; w0.x = pk2(ot0[4 * a] * inv, ot0[4 * a + 1] * inv); w0.y = pk2(ot0[4 * a + 2] * inv, ot0[4 * a + 3] * inv);
        w1.x = pk2(ot1[4 * a] * inv, ot1[4 * a + 1] * inv); w1.y = pk2(ot1[4 * a + 2] * inv, ot1[4 * a + 3] * inv);
        *(u32x2*)(op + 8 * a) = w0; *(u32x2*)(op + 32 + 8 * a) = w1;
    }
}

template <int VAR>
__device__ __forceinline__ void attn_unit_sm(const Ptrs& P, int b, int h, int qb, LAS3 unsigned char* lds) {
    constexpr int DQ = (VAR == 2) ? 96 : 64, ND = DQ / 16, KP = DQ * 2 + 16;
    int tid_ = threadIdx.x; asm volatile("" : "+v"(tid_)); const int tid = tid_, lane = tid & 63, r32 = lane & 31, hi = lane >> 5; const int wid = __builtin_amdgcn_readfirstlane(tid >> 6);
    const size_t rowbase = (size_t)b * SEQ; const int q0 = qb * 256, qrow = q0 + wid * 32 + r32;
    const int cw = 4 * qb + (wid >> 1);
    const int t_hi = 4 * qb + 3, t_lo = (VAR == 0) ? ((4 * qb - 8) > 0 ? (4 * qb - 8) : 0) : 0, nt = t_hi - t_lo + 1;
    const int w_lo = (VAR == 0) ? ((cw - 8) > 0 ? (cw - 8) : 0) : 0, w_hi = cw;
    LAS3 float* TB = (LAS3 float*)(lds + TB_OFF);
    if (VAR == 0) { for (int i = tid; i < 257; i += 512) TB[i] = P.bias[h * 257 + i] * LOG2E; }
    bf16x8 qf[ND];
    { const bf16_t* qp = P.Q + (rowbase + qrow) * P.qp + h * P.qh + hi * 8;
#pragma unroll
      for (int d0 = 0; d0 < ND; ++d0) qf[d0] = *(const bf16x8*)(qp + d0 * 16); }
    const float cbase = (VAR == 3) ? P.bias[((size_t)(b * 8 + h)) * SEQ + qrow] : 0.f;
    const int lkey = tid >> 3, lj = tid & 7;
    const bf16_t* kg = P.K + (rowbase + lkey) * P.kp + h * P.kh + lj * 8;
    const bf16_t* vg = P.V + (rowbase + lkey) * P.vp + h * P.vh + lj * 8;
    const bf16_t* k2g = (VAR == 2) ? P.K2 + (rowbase + (tid >> 2)) * P.k2p + (tid & 3) * 8 : nullptr;
    const float* fg = (VAR == 3) ? P.bias + ((size_t)(b * 8 + h)) * SEQ + (tid & 15) * 4 : nullptr;
    const int kw = lkey * KP + lj * 16, vw = KBUF + (lj >> 2) * 4096 + lkey * 64 + (lj & 3) * 16, k2w = (tid >> 2) * KP + 128 + (tid & 3) * 16, fw = KBUF + VBUF + (tid & 15) * 16;
    u32x4 rk0, rv0, rk20, rk1, rv1, rk21; f32x4 rf0, rf1;
#define ATT_LOAD(t, S) do { const size_t ko_ = (size_t)(t) * 64; rk##S = *(const u32x4*)(kg + ko_ * P.kp); rv##S = *(const u32x4*)(vg + ko_ * P.vp); \
        if (VAR == 2) { if (tid < 256) rk2##S = *(const u32x4*)(k2g + ko_ * P.k2p); } if (VAR == 3) { if (tid < 16) rf##S = *(const f32x4*)(fg + ko_); } } while (0)
#define ATT_STORE(bufo, S) do { *(LAS3 u32x4*)(lds + (bufo) + kw) = rk##S; *(LAS3 u32x4*)(lds + (bufo) + vw) = rv##S; \
        if (VAR == 2) { if (tid < 256) *(LAS3 u32x4*)(lds + (bufo) + k2w) = rk2##S; } if (VAR == 3) { if (tid < 16) *(LAS3 f32x4*)(lds + (bufo) + fw) = rf##S; } } while (0)
    const int pi = (r32 & ~12) | ((r32 & 4) << 1) | ((r32 & 8) >> 1);
    const int ka = pi * KP + hi * 16;
    const int va = KBUF + (8 * hi + ((lane & 15) >> 2)) * 64 + (16 * ((lane >> 4) & 1) + 4 * (lane & 3)) * 2;
    float m_run = 0.f, l_run = 0.f;
    f32x16 ot0 = {}, ot1 = {}, negm;
#pragma unroll
    for (int r = 0; r < 16; ++r) negm[r] = cbase;
    asm volatile("" : "+v"(negm));
    f32x16 sA0 = {}, sA1 = {}, sB0 = {}, sB1 = {};
#define SM_QK(SA, SB, kbo) do { const LAS3 unsigned char* kb_ = lds + (kbo) + ka; __builtin_amdgcn_s_setprio(1); \
        _Pragma("unroll") for (int d0 = 0; d0 < ND; ++d0) { \
            const bf16x8 k0_ = *(const LAS3 bf16x8*)(kb_ + d0 * 32), k1_ = *(const LAS3 bf16x8*)(kb_ + 32 * KP + d0 * 32); \
            if (d0 == 0) { SA = __builtin_amdgcn_mfma_f32_32x32x16_bf16(k0_, qf[0], negm, 0, 0, 0); SB = __builtin_amdgcn_mfma_f32_32x32x16_bf16(k1_, qf[0], negm, 0, 0, 0); } \
            else { SA = __builtin_amdgcn_mfma_f32_32x32x16_bf16(k0_, qf[d0], SA, 0, 0, 0); SB = __builtin_amdgcn_mfma_f32_32x32x16_bf16(k1_, qf[d0], SB, 0, 0, 0); } } __builtin_amdgcn_s_setprio(0); } while (0)
#define SM_BIAS(SA, SB, tn, bo) do { \
        if (VAR == 0) { \
            if (cw - (tn) >= 3) { const float c_ = TB[256]; _Pragma("unroll") for (int r = 0; r < 16; ++r) { SA[r] += c_; SB[r] += c_; } } \
            else { const int d0_ = qrow - 64 * (tn) - 8 * hi + 128; \
                _Pragma("unroll") for (int r = 0; r < 16; ++r) { int ia = d0_ - 16 * (r >> 3) - (r & 7), ib = ia - 32; ia = ia < 0 ? 0 : (ia > 256 ? 256 : ia); ib = ib < 0 ? 0 : (ib > 256 ? 256 : ib); \
                    SA[r] += TB[ia]; SB[r] += TB[ib]; } } } \
        if (VAR == 3) { const LAS3 float* F_ = (const LAS3 float*)(lds + (bo) + KBUF + VBUF) + 8 * hi; \
            _Pragma("unroll") for (int a = 0; a < 2; ++a) { \
                const f32x4 fa0 = *(const LAS3 f32x4*)(F_ + 16 * a), fa1 = *(const LAS3 f32x4*)(F_ + 16 * a + 4), fb0 = *(const LAS3 f32x4*)(F_ + 32 + 16 * a), fb1 = *(const LAS3 f32x4*)(F_ + 32 + 16 * a + 4); \
                _Pragma("unroll") for (int e = 0; e < 4; ++e) { SA[8 * a + e] -= fa0[e]; SA[8 * a + 4 + e] -= fa1[e]; SB[8 * a + e] -= fb0[e]; SB[8 * a + 4 + e] -= fb1[e]; } } \
            if ((tn) >= cw) { const int lim_ = qrow - 64 * (tn) - 8 * hi; \
                _Pragma("unroll") for (int r = 0; r < 16; ++r) { const int kk = 16 * (r >> 3) + (r & 7); if (kk > lim_) SA[r] = NEG_BIG; if (kk + 32 > lim_) SB[r] = NEG_BIG; } } } } while (0)
#define SM_BIAS_C(SA, SB, tn) do { if (VAR == 2) { if ((tn) > cw) { _Pragma("unroll") for (int r = 0; r < 16; ++r) { SA[r] = NEG_BIG; SB[r] = NEG_BIG; } } } } while (0)
#define SM_REF(SA, SB, HASN, NA, NB) do { \
        float mx_ = fmaxf(SA[0], SB[0]); _Pragma("unroll") for (int r = 1; r < 16; ++r) mx_ = fmaxf(mx_, fmaxf(SA[r], SB[r])); \
        mx_ = lane32_max(mx_); \
        if (__any(mx_ > 8.0f)) { const float dl_ = fmaxf(mx_, 0.f); m_run += dl_; \
            _Pragma("unroll") for (int r = 0; r < 16; ++r) { SA[r] -= dl_; SB[r] -= dl_; } \
            if (HASN) { _Pragma("unroll") for (int r = 0; r < 16; ++r) { NA[r] -= dl_; NB[r] -= dl_; } } \
            const float nm_ = cbase - m_run; _Pragma("unroll") for (int r = 0; r < 16; ++r) negm[r] = nm_; asm volatile("" : "+v"(negm)); \
            { const float f_ = __builtin_amdgcn_exp2f(-dl_); l_run *= f_; _Pragma("unroll") for (int r = 0; r < 16; ++r) { ot0[r] *= f_; ot1[r] *= f_; } } } } while (0)
#define SM_PV(SA, SB, vbo) do { const LAS3 unsigned char* vb_ = lds + (vbo) + va; float ls_ = 0.f; \
        _Pragma("unroll") for (int s = 0; s < 4; ++s) { u32x4 w_; \
            _Pragma("unroll") for (int j = 0; j < 4; ++j) { float e0_, e1_; \
                if (s < 2) { e0_ = __builtin_amdgcn_exp2f(SA[8 * (s & 1) + 2 * j]); e1_ = __builtin_amdgcn_exp2f(SA[8 * (s & 1) + 2 * j + 1]); } \
                else { e0_ = __builtin_amdgcn_exp2f(SB[8 * (s & 1) + 2 * j]); e1_ = __builtin_amdgcn_exp2f(SB[8 * (s & 1) + 2 * j + 1]); } \
                ls_ += e0_ + e1_; w_[j] = pk2(e0_, e1_); } \
            const bf16x8 p_ = __builtin_bit_cast(bf16x8, w_); \
            const s16x4 a0 = vtr(vb_ + s * 1024), a1 = vtr(vb_ + s * 1024 + 256), c0 = vtr(vb_ + 4096 + s * 1024), c1 = vtr(vb_ + 4096 + s * 1024 + 256); \
            const bf16x8 v0 = {a0[0], a0[1], a0[2], a0[3], a1[0], a1[1], a1[2], a1[3]}, v1 = {c0[0], c0[1], c0[2], c0[3], c1[0], c1[1], c1[2], c1[3]}; \
            ot0 = __builtin_amdgcn_mfma_f32_32x32x16_bf16(v0, p_, ot0, 0, 0, 0); \
            ot1 = __builtin_amdgcn_mfma_f32_32x32x16_bf16(v1, p_, ot1, 0, 0, 0); } \
        l_run += ls_; } while (0)
#define SM_STEP(CA, CB, NA, NB, it, LS, SS) do { \
        const bool more_ = ((it) + 2 < nt); \
        if ((it) + 3 < nt) ATT_LOAD((it) + 3, LS); \
        SM_REF(CA, CB, false, NA, NB); SM_QK(NA, NB, b_next); SM_PV(CA, CB, b_cur); SM_BIAS(NA, NB, (it) + 1, b_next); SM_BIAS_C(NA, NB, (it) + 1); \
        if (more_) ATT_STORE(b_store, SS); \
        asm volatile("s_waitcnt lgkmcnt(0)\n\ts_barrier" ::: "memory");     \
        { const int tb_ = b_cur; b_cur = b_next; b_next = b_store; b_store = tb_; } } while (0)
    ATT_LOAD(0, 0); ATT_LOAD(1, 1); ATT_STORE(0, 0); ATT_STORE(BUFB, 1); ATT_LOAD(2, 1);
    __syncthreads();
    int b_cur = 0, b_next = BUFB, b_store = 2 * BUFB;
    SM_QK(sA0, sA1, 0); SM_BIAS(sA0, sA1, 0, 0);
    { float mx_ = fmaxf(sA0[0], sA1[0]);
#pragma unroll
      for (int r = 1; r < 16; ++r) mx_ = fmaxf(mx_, fmaxf(sA0[r], sA1[r]));
      mx_ = lane32_max(mx_); m_run = mx_;
#pragma unroll
      for (int r = 0; r < 16; ++r) { sA0[r] -= mx_; sA1[r] -= mx_; negm[r] = cbase - mx_; }
      asm volatile("" : "+v"(negm)); }
    int it = 0;
    for (; it + 2 < nt; it += 2) {
        SM_STEP(sA0, sA1, sB0, sB1, it, 0, 1);
        SM_STEP(sB0, sB1, sA0, sA1, it + 1, 1, 0);
    }
    SM_STEP(sA0, sA1, sB0, sB1, it, 0, 1);
    SM_REF(sB0, sB1, false, sA0, sA1); SM_PV(sB0, sB1, b_cur);
    __syncthreads();
#undef SM_STEP
#undef SM_PV
#undef SM_REF
#undef SM_BIAS
#undef SM_BIAS_C
#undef SM_QK
#undef ATT_LOAD
#undef ATT_STORE
    const float lt = lane32_sum(l_run); const float inv = 1.0f / lt;
    bf16_t* op = P.O + (rowbase + qrow) * DM + P.oc + h * 64 + 4 * hi;
#pragma unroll
    for (int a = 0; a < 4; ++a) {
        u32x2 w0, w1; w0.x = pk2(ot0[4 * a] * inv, ot0[4 * a + 1] * inv); w0.y = pk2(ot0[4 * a + 2] * inv, ot0[4 * a + 3] * inv);
        w1.x = pk2(ot1[4 * a] * inv, ot1[4 * a + 1] * inv); w1.y = pk2(ot1[4 * a + 2] * inv, ot1[4 * a + 3] * inv);
        *(u32x2*)(op + 8 * a) = w0; *(u32x2*)(op + 32 + 8 * a) = w1;
    }
}
}
#define LAS __attribute__((address_space(3)))
typedef unsigned short bf16;
typedef unsigned v4u __attribute__((ext_vector_type(4)));
typedef float f32x4 __attribute__((ext_vector_type(4)));
typedef float f32x2 __attribute__((ext_vector_type(2)));
constexpr int NWAVES = 8, NTHR = 512;
constexpr size_t MiB = 1u << 20;
constexpr size_t WS_SS = 0;
constexpr size_t WS_QCTR = 7 * 131072;
constexpr size_t WS_BAR = WS_QCTR + 64 * 256;
constexpr size_t WS_KMAX = WS_BAR + 3456 * 4;
constexpr size_t WS_ROPE = 1 * MiB;
constexpr size_t WS_LF = 2 * MiB;
constexpr size_t WS_CUMF = 3 * MiB;
constexpr size_t WS_W_AB = 4 * MiB, WS_W_OAB = 10 * MiB, WS_W_GU0 = 12 * MiB, WS_W_DN0 = 23 * MiB, WS_W_CD = 29 * MiB, WS_W_UQ = 34 * MiB, WS_W_UKV = 35 * MiB,
                 WS_W_OCD = 36 * MiB, WS_W_GU1 = 38 * MiB, WS_W_DN1 = 49 * MiB;
constexpr size_t WS_XB = 56 * MiB;
constexpr size_t WS_BIG = 120 * MiB;
constexpr size_t WS_END = 472 * MiB;
constexpr int RING_BYTES = 131072, LDS_BYTES = 147456;

struct Args {
    const float *x, *ab_norm, *ab_w_in, *ab_rel_bias, *ab_w_o, *cd_norm, *cd_w_in, *cd_q_norm, *cd_w_uq, *cd_kv_norm, *cd_w_ukv, *cd_b_f, *cd_w_o,
                *ffn_norm, *ffn_w_gate, *ffn_w_up, *ffn_conv_w, *ffn_conv_b, *ffn_w_down, *final_norm;
    float* out; unsigned char* ws;
};

__device__ __forceinline__ unsigned f2bf(float f) { unsigned u = __builtin_bit_cast(unsigned, f); return (u + 0x7fffu + ((u >> 16) & 1u)) >> 16; }
__device__ __forceinline__ unsigned pk2f(float lo, float hi) { return f2bf(lo) | (f2bf(hi) << 16); }
__device__ __forceinline__ float bf_lo(unsigned w) { return __uint_as_float(w << 16); }
__device__ __forceinline__ float bf_hi(unsigned w) { return __uint_as_float(w & 0xffff0000u); }
__device__ __forceinline__ float wave_sum(float v) {
#pragma unroll
    for (int o = 1; o < 64; o <<= 1) v += __shfl_xor(v, o);
    return v;
}

struct WDesc { const float* W; int K, N, Npad; bf16* WT; int row_off; int ilv; const float* gain; int s0lo, s0hi; float s0; int s1lo, s1hi; float s1; };
__device__ __forceinline__ void transpose_item(const WDesc& d, LAS float* scr, int item, int lane) {
    const int nblk = d.Npad / 32, kb = item / nblk, nb = item % nblk, k0 = 64 * kb, n0 = 32 * nb;
    const int n = n0 + (lane & 31);
    const float cs = (n >= d.s0lo && n < d.s0hi) ? d.s0 : ((n >= d.s1lo && n < d.s1hi) ? d.s1 : 1.0f);
    float wv[32];
#pragma unroll
    for (int i = 0; i < 32; ++i) { const int kk = 2 * i + (lane >> 5); wv[i] = (n < d.N) ? d.W[(size_t)(k0 + kk) * d.N + n] : 0.f; }
    const float g0 = d.gain ? d.gain[k0 + lane] : 1.0f;
#pragma unroll
    for (int i = 0; i < 32; ++i) { const int kk = 2 * i + (lane >> 5); const float g = __shfl(g0, kk); scr[kk * 33 + (lane & 31)] = wv[i] * g * cs; }
    asm volatile("s_waitcnt lgkmcnt(0)" ::: "memory");
    const int c = lane & 7;
#pragma unroll
    for (int j = 0; j < 4; ++j) { const int nn = (lane >> 3) + 8 * j; const LAS float* s = scr + (8 * c) * 33 + nn;
        v4u o; o.x = pk2f(s[0 * 33], s[1 * 33]); o.y = pk2f(s[2 * 33], s[3 * 33]); o.z = pk2f(s[4 * 33], s[5 * 33]); o.w = pk2f(s[6 * 33], s[7 * 33]);
        const int rowb = d.ilv ? (256 * (n0 >> 7) + (n0 & 127) + d.row_off) : (d.row_off + n0);
        *(v4u*)(d.WT + (size_t)(rowb + nn) * d.K + k0 + 8 * c) = o; }
    asm volatile("s_waitcnt lgkmcnt(0)" ::: "memory");
}
__device__ __forceinline__ WDesc wdesc(const Args& a, int mi) {
    unsigned char* ws = a.ws; WDesc d; d.gain = nullptr; d.row_off = 0; d.ilv = 0; d.s0lo = d.s0hi = d.s1lo = d.s1hi = 0; d.s0 = d.s1 = 1.f;
    switch (mi) {
    case 0: d.W = a.ab_w_in; d.K = DM; d.N = AB_COLS; d.Npad = AB_COLS; d.WT = (bf16*)(ws + WS_W_AB); d.gain = a.ab_norm; d.s0lo = 0; d.s0hi = 512; d.s0 = 0.125f * LOG2E; d.s1lo = 1536; d.s1hi = 2048; d.s1 = 0.125f; break;
    case 1: d.W = a.ab_w_o; d.K = DM; d.N = DM; d.Npad = DM; d.WT = (bf16*)(ws + WS_W_OAB); break;
    case 2: d.W = a.ffn_w_gate; d.K = DM; d.N = FF; d.Npad = FF; d.WT = (bf16*)(ws + WS_W_GU0); d.gain = a.ffn_norm; d.ilv = 1; break;
    case 3: d.W = a.ffn_w_up; d.K = DM; d.N = FF; d.Npad = FF; d.WT = (bf16*)(ws + WS_W_GU0); d.row_off = 128; d.ilv = 1; d.gain = a.ffn_norm; break;
    case 4: d.W = a.ffn_w_down; d.K = FF; d.N = DM; d.Npad = DM; d.WT = (bf16*)(ws + WS_W_DN0); break;
    case 5: d.W = a.cd_w_in; d.K = DM; d.N = CD_COLS; d.Npad = CD_PAD; d.WT = (bf16*)(ws + WS_W_CD); d.gain = a.cd_norm; d.s0lo = 672; d.s0hi = 1184; d.s0 = 0.125f * LOG2E; break;
    case 6: d.W = a.cd_w_uq; d.K = Q_RANK; d.N = QC_COLS; d.Npad = QC_COLS; d.WT = (bf16*)(ws + WS_W_UQ); d.gain = a.cd_q_norm; d.s0lo = 0; d.s0hi = QC_COLS; d.s0 = 0.10206207261596575f * LOG2E; break;
    case 7: d.W = a.cd_w_ukv; d.K = KV_RANK; d.N = KVC_COLS; d.Npad = KVC_COLS; d.WT = (bf16*)(ws + WS_W_UKV); d.gain = a.cd_kv_norm; break;
    case 8: d.W = a.cd_w_o; d.K = DM; d.N = DM; d.Npad = DM; d.WT = (bf16*)(ws + WS_W_OCD); break;
    case 9: d.W = a.ffn_w_gate + (size_t)DM * FF; d.K = DM; d.N = FF; d.Npad = FF; d.WT = (bf16*)(ws + WS_W_GU1); d.gain = a.ffn_norm + DM; d.ilv = 1; break;
    case 10: d.W = a.ffn_w_up + (size_t)DM * FF; d.K = DM; d.N = FF; d.Npad = FF; d.WT = (bf16*)(ws + WS_W_GU1); d.row_off = 128; d.ilv = 1; d.gain = a.ffn_norm + DM; break;
    default: d.W = a.ffn_w_down + (size_t)FF * DM; d.K = FF; d.N = DM; d.Npad = DM; d.WT = (bf16*)(ws + WS_W_DN1); break;
    }
    return d;
}
__device__ __forceinline__ int witems(int mi) {
    switch (mi) { case 0: return (DM / 64) * (AB_COLS / 32); case 1: case 8: return (DM / 64) * (DM / 32); case 2: case 3: case 9: case 10: return (DM / 64) * (FF / 32);
                  case 4: case 11: return (FF / 64) * (DM / 32); case 5: return (DM / 64) * (CD_PAD / 32); case 6: return (Q_RANK / 64) * (QC_COLS / 32); default: return (KV_RANK / 64) * (KVC_COLS / 32); }
}

__device__ __forceinline__ void p0_prologue(const Args& a, LAS unsigned char* lds, int gw, int NGW, int lane, int wave) {
    unsigned char* ws = a.ws;
    { float* z = (float*)(ws + WS_SS); const int gt = gw * 64 + lane, GT = NGW * 64;
      for (int i = MTOK + gt; i < 7 * MTOK + 64 * 64 + 3456 + 64; i += GT) z[i] = 0.f; }
    { f32x2* rt = (f32x2*)(ws + WS_ROPE); const int gt = gw * 64 + lane, GT = NGW * 64;
      for (int i = gt; i < SEQ * 16; i += GT) { const int pos = i >> 4, j = i & 15;
          const float inv = exp2f(-(float)j * (13.287712379549449f / 16.0f));
          const float ang = (float)pos * inv;
          const double turns = (double)ang * 0.15915494309189535; const float fr = (float)(turns - floor(turns));
          rt[i] = (f32x2){__builtin_amdgcn_cosf(fr), __builtin_amdgcn_sinf(fr)}; } }
    LAS float* scr = (LAS float*)(lds + wave * 16384);
    { int base = 0;
      for (int mi = 0; mi < 12; ++mi) { const int ni = witems(mi); const WDesc d = wdesc(a, mi);
          int first = gw - (base % NGW); if (first < 0) first += NGW;
          for (int it = first; it < ni; it += NGW) transpose_item(d, scr, it, lane);
          base += ni; } }
    { float* ss0 = (float*)(ws + WS_SS); bf16* xb = (bf16*)(ws + WS_XB);
      for (int m0 = gw * 4; m0 < MTOK; m0 += NGW * 4) {
          f32x4 v[4][4];
#pragma unroll
          for (int r = 0; r < 4; ++r) { const f32x4* xr = (const f32x4*)(a.x + (size_t)(m0 + r) * DM) + lane;
#pragma unroll
              for (int j = 0; j < 4; ++j) v[r][j] = __builtin_nontemporal_load(xr + 64 * j); }
#pragma unroll
          for (int r = 0; r < 4; ++r) { unsigned long long* o8 = (unsigned long long*)(xb + (size_t)(m0 + r) * DM) + lane; float s = 0.f;
#pragma unroll
              for (int j = 0; j < 4; ++j) { const f32x4 w = v[r][j]; s += (w.x * w.x + w.y * w.y) + (w.z * w.z + w.w * w.w); o8[64 * j] = (unsigned long long)pk2f(w.x, w.y) | ((unsigned long long)pk2f(w.z, w.w) << 32); }
              s = wave_sum(s); if (lane == 0) ss0[m0 + r] = s; } } }
}

__device__ __forceinline__ void act_phase(bf16* gu, const float* cw, const float* cb, int gtid, int GT) {
    constexpr int NCH = FF / 8, RB = 32;
    for (int it = gtid; it < (MTOK / RB) * NCH; it += GT) {
        const int ch = it % NCH, rb = it / NCH, r0 = rb * RB, c = ch * 8;
        float w0[8], w1[8], w2[8], bb[8];
#pragma unroll
        for (int e = 0; e < 8; ++e) { w0[e] = cw[c + e]; w1[e] = cw[FF + c + e]; w2[e] = cw[2 * FF + c + e]; bb[e] = cb[c + e]; }
        float g2[8], g1[8];
        if ((r0 & (SEQ - 1)) == 0) {
#pragma unroll
            for (int e = 0; e < 8; ++e) { g2[e] = 0.f; g1[e] = 0.f; }
        } else {
            const v4u a2 = *(const v4u*)(gu + (size_t)(r0 - 2) * FF2 + c), a1 = *(const v4u*)(gu + (size_t)(r0 - 1) * FF2 + c);
            g2[0] = bf_lo(a2.x); g2[1] = bf_hi(a2.x); g2[2] = bf_lo(a2.y); g2[3] = bf_hi(a2.y); g2[4] = bf_lo(a2.z); g2[5] = bf_hi(a2.z); g2[6] = bf_lo(a2.w); g2[7] = bf_hi(a2.w);
            g1[0] = bf_lo(a1.x); g1[1] = bf_hi(a1.x); g1[2] = bf_lo(a1.y); g1[3] = bf_hi(a1.y); g1[4] = bf_lo(a1.z); g1[5] = bf_hi(a1.z); g1[6] = bf_lo(a1.w); g1[7] = bf_hi(a1.w);
        }
#pragma unroll 4
        for (int r = 0; r < RB; ++r) {
            bf16* gp = gu + (size_t)(r0 + r) * FF2 + c;
            const v4u ag = *(const v4u*)gp, au = *(const v4u*)(gp + FF);
            float g0[8], uu[8], y[8];
            g0[0] = bf_lo(ag.x); g0[1] = bf_hi(ag.x); g0[2] = bf_lo(ag.y); g0[3] = bf_hi(ag.y); g0[4] = bf_lo(ag.z); g0[5] = bf_hi(ag.z); g0[6] = bf_lo(ag.w); g0[7] = bf_hi(ag.w);
            uu[0] = bf_lo(au.x); uu[1] = bf_hi(au.x); uu[2] = bf_lo(au.y); uu[3] = bf_hi(au.y); uu[4] = bf_lo(au.z); uu[5] = bf_hi(au.z); uu[6] = bf_lo(au.w); uu[7] = bf_hi(au.w);
#pragma unroll
            for (int e = 0; e < 8; ++e) { const float xg = w0[e] * g2[e] + w1[e] * g1[e] + w2[e] * g0[e] + bb[e]; y[e] = xg * __builtin_amdgcn_rcpf(1.0f + __expf(-xg)) * uu[e]; g2[e] = g1[e]; g1[e] = g0[e]; }
            v4u o; o.x = pk2f(y[0], y[1]); o.y = pk2f(y[2], y[3]); o.z = pk2f(y[4], y[5]); o.w = pk2f(y[6], y[7]);
            *(v4u*)(gp + FF) = o;
        }
    }
}

__device__ __forceinline__ void ffn_fixup(const float* gf, const float* uf, const float* gl, const float* cw, const float* cb, bf16* Y, int gtid, int GT) {
    constexpr int NC4 = FF / 4, NG = MTOK / 64;
    for (int it = gtid; it < NG * 2 * NC4; it += GT) {
        const int c = (it % NC4) * 4, j = (it / NC4) & 1, g = it / (2 * NC4);
        const bool seq0 = (g & (SEQ / 64 - 1)) == 0;
        const f32x4 z = {0.f, 0.f, 0.f, 0.f};
        const f32x4 g0 = *(const f32x4*)(gf + (size_t)(g * 2 + j) * FF + c), u0 = *(const f32x4*)(uf + (size_t)(g * 2 + j) * FF + c);
        const f32x4 l0 = seq0 ? z : *(const f32x4*)(gl + (size_t)((g - 1) * 2 + 0) * FF + c), l1 = seq0 ? z : *(const f32x4*)(gl + (size_t)((g - 1) * 2 + 1) * FF + c);
        const f32x4 g1 = j ? *(const f32x4*)(gf + (size_t)(g * 2) * FF + c) : l1, g2 = j ? l1 : l0;
        const f32x4 w0 = *(const f32x4*)(cw + c), w1 = *(const f32x4*)(cw + FF + c), w2 = *(const f32x4*)(cw + 2 * FF + c), bb = *(const f32x4*)(cb + c);
        const f32x4 xg = w0 * g2 + w1 * g1 + w2 * g0 + bb; float y[4];
#pragma unroll
        for (int e = 0; e < 4; ++e) y[e] = xg[e] * __builtin_amdgcn_rcpf(1.0f + __expf(-xg[e])) * u0[e];
        unsigned long long o = (unsigned long long)pk2f(y[0], y[1]) | ((unsigned long long)pk2f(y[2], y[3]) << 32);
        *(unsigned long long*)(Y + (size_t)(g * 64 + j) * FF + c) = o;
    }
}

__device__ __forceinline__ void cumf_block(const float* lf, float* cumf, int bh, LAS float* scr, int tid) {
    const int b = bh >> 3, h = bh & 7, t0 = tid * 16, lane = tid & 63, wave = tid >> 6;
    float v[16]; float s = 0.f;
#pragma unroll
    for (int i = 0; i < 16; ++i) { s += lf[((size_t)b * SEQ + t0 + i) * 8 + h]; v[i] = s; }
    float incl = s;
#pragma unroll
    for (int o = 1; o < 64; o <<= 1) { const float up = __shfl_up(incl, o); if (lane >= o) incl += up; }
    if (lane == 63) scr[wave] = incl;
    __syncthreads();
    float woff = 0.f;
    for (int w = 0; w < wave; ++w) woff += scr[w];
    const float off = woff + incl - s;
    float* o = cumf + (size_t)bh * SEQ + t0;
#pragma unroll
    for (int i = 0; i < 16; ++i) o[i] = off + v[i];
    __syncthreads();
}

__device__ __forceinline__ void kmax_block(const bf16* kd  , unsigned* kmax_bits, int blk, int tid) {
    const int bh = blk >> 3, seg = blk & 7, b = bh >> 3, h = bh & 7, lj = tid & 7, kl = tid >> 3;
    const bf16* p = kd + ((size_t)b * SEQ + seg * 1024 + kl) * CD_PAD + h * 64 + lj * 8;
    v4u w[16];
#pragma unroll
    for (int i = 0; i < 16; ++i) w[i] = *(const v4u*)(p + (size_t)i * 64 * CD_PAD);
    float mx = 0.f;
#pragma unroll
    for (int i = 0; i < 16; ++i) { float s = 0.f;
#pragma unroll
        for (int e = 0; e < 4; ++e) { const float lo = bf_lo(w[i][e]), hi = bf_hi(w[i][e]); s += lo * lo + hi * hi; }
        s += __shfl_xor(s, 1); s += __shfl_xor(s, 2); s += __shfl_xor(s, 4); mx = fmaxf(mx, s); }
#pragma unroll
    for (int o = 8; o < 64; o <<= 1) mx = fmaxf(mx, __shfl_xor(mx, o));
    if ((tid & 63) == 0) atomicMax(kmax_bits + bh, __float_as_uint(sqrtf(mx)));
}

template <int LAYER>
__device__ __forceinline__ void attn_phase(const att::Ptrs& P0, const att::Ptrs& P1, unsigned* ctr, LAS unsigned char* lds) {
    const int x0 = blockIdx.x & 7;
    volatile LAS int* qidx = (volatile LAS int*)(lds + att::QIDX_OFF);
#pragma unroll 1
    for (int q = 0; q < 8; ++q) {
        const int x = (x0 + q) & 7; unsigned* my = ctr + x * 64;
        for (;;) {
            if (threadIdx.x == 0) *qidx = (int)atomicAdd(my, 1u);
            __syncthreads();
            const int i = *qidx;
            __syncthreads();
            if (i >= 256) break;
            if (LAYER == 0) {
                if (i < 128) att::attn_unit<1>(P1, i & 3, x, 31 - (i >> 2), lds);
                else { const int j = i - 128; att::attn_unit<0>(P0, j >> 5, x, 31 - (j & 31), lds); }
            } else {
                const int j = i & 127, qb = 31 - (j >> 2), b = j & 3;
                if (i >= 128) att::attn_unit<3>(P1, b, x, qb, lds);
                else att::attn_unit_sm<2>(P0, b, x, qb, lds);
            }
        }
    }
}

typedef __attribute__((address_space(1))) unsigned gu32;
#define XB_TMO      128
#define XB_XCNT(j)  (256  + 64 * (j))
#define XB_XSUB(j)  (1280 + 64 * (j))
#define XB_XGEN(j)  (2304 + 64 * (j))
#define XB_TOP      3328
#define XB_TOPGEN   3392
#define XCD_BAR_WORDS 3456
#define XB_SPIN_CAP (1u << 18)

__device__ __forceinline__ unsigned xb_ld(unsigned* p)              { return __hip_atomic_load(p, __ATOMIC_RELAXED, __HIP_MEMORY_SCOPE_AGENT); }
__device__ __forceinline__ unsigned xb_add(unsigned* p, unsigned v) { return __hip_atomic_fetch_add(p, v, __ATOMIC_RELAXED, __HIP_MEMORY_SCOPE_AGENT); }
__device__ __forceinline__ unsigned xb_xcc_id() { return (unsigned)__builtin_amdgcn_s_getreg((3 << 11) | 20) & 0xFu; }
#define XB_SPIN(cond, bar) do { unsigned _sp = 0; while (cond) { __builtin_amdgcn_s_sleep(1); \
    if ((++_sp & 255u) == 0u) { if (xb_ld(&(bar)[XB_TMO])) break; if (_sp > XB_SPIN_CAP) { atomicAdd(&(bar)[XB_TMO], 1u); break; } } } } while (0)

struct XcdBarrier {
    unsigned* bar; unsigned x;
    volatile LAS unsigned* st;
};

__device__ __forceinline__ XcdBarrier xcd_barrier_post(unsigned* bar, volatile LAS unsigned* st) {
    XcdBarrier b; b.bar = bar; b.x = xb_xcc_id(); b.st = st;
    if (threadIdx.x == 0) (void)xb_add(&bar[XB_XCNT(b.x)], 1u);
    return b;
}
__device__ __forceinline__ void xcd_barrier_complete(unsigned* bar, unsigned x, unsigned& nloc, unsigned& nx) {
    const unsigned G = gridDim.x * gridDim.y * gridDim.z;
    unsigned sum, cnt, mine, sp = 0u;
    for (;;) {
        sum = 0u; cnt = 0u; mine = 0u;
#pragma unroll
        for (unsigned j = 0; j < 16; ++j) { const unsigned c = xb_ld(&bar[XB_XCNT(j)]); sum += c; cnt += (c > 0u) ? 1u : 0u; mine = (j == x) ? c : mine; }
        if (sum == G) break;
        __builtin_amdgcn_s_sleep(1);
        if ((++sp & 255u) == 0u) { if (xb_ld(&bar[XB_TMO])) break; if (sp > XB_SPIN_CAP) { atomicAdd(&bar[XB_TMO], 1u); break; } }
    }
    nloc = mine > 0u ? mine : 1u; nx = cnt > 0u ? cnt : 1u;
}

__device__ __forceinline__ void xcd_barrier(const XcdBarrier& b) {
    asm volatile("s_waitcnt vmcnt(0)" ::: "memory");
    __syncthreads();
    if (threadIdx.x == 0) {
        unsigned* bar = b.bar;
        __builtin_amdgcn_s_waitcnt(0);
        unsigned nloc = b.st[0], nx = b.st[1];
        if (nloc == 0u) { xcd_barrier_complete(bar, b.x, nloc, nx); b.st[0] = nloc; b.st[1] = nx; }
        const unsigned old = xb_add(&bar[XB_XSUB(b.x)], 1u);
        const unsigned gen = old / nloc;
        if (old + 1u == (gen + 1u) * nloc) {
            __builtin_amdgcn_fence(__ATOMIC_RELEASE, "agent");
            asm volatile("s_waitcnt vmcnt(0)" ::: "memory");
            const unsigned og = xb_add(&bar[XB_TOP], 1u);
            const unsigned tg = og / nx;
            if (og + 1u == (tg + 1u) * nx) xb_add(&bar[XB_TOPGEN], 1u);
            else XB_SPIN(xb_ld(&bar[XB_TOPGEN]) == tg, bar);
            __builtin_amdgcn_fence(__ATOMIC_ACQUIRE, "agent");
            xb_add(&bar[XB_XGEN(b.x)], 1u);
            asm volatile("s_waitcnt vmcnt(0)" ::: "memory");
        } else {
            XB_SPIN(xb_ld(&bar[XB_XGEN(b.x)]) == gen, bar);
            __builtin_amdgcn_fence(__ATOMIC_ACQUIRE, "agent");
            asm volatile("s_waitcnt vmcnt(0)" ::: "memory");
        }
    }
    __syncthreads();
}

__device__ __forceinline__ int fresh_tid() { int t = threadIdx.x; asm volatile("" : "+v"(t)); return t; }
__global__ void __launch_bounds__(NTHR, 2) mk_fwd(Args a) {
    extern __shared__ __attribute__((aligned(16))) unsigned char lds_raw[];
    LAS unsigned char* lds = (LAS unsigned char*)lds_raw;
    cg::grid_group grid = cg::this_grid();
    const int G = gridDim.x, bx = blockIdx.x;
    const int NGW = G * NWAVES, GT = G * NTHR;
    unsigned char* ws = a.ws;
    float* SS = (float*)(ws + WS_SS);
    float *ss0 = SS, *ss1 = SS + MTOK, *ss2 = SS + 2 * MTOK, *ss3 = SS + 3 * MTOK, *ss4 = SS + 4 * MTOK, *ssq = SS + 5 * MTOK, *sskv = SS + 6 * MTOK;
    unsigned* qctr = (unsigned*)(ws + WS_QCTR);
    const f32x2* rope = (const f32x2*)(ws + WS_ROPE);
    float* lf = (float*)(ws + WS_LF); float* cumf = (float*)(ws + WS_CUMF); const float* kmaxp = (const float*)(ws + WS_KMAX);
    bf16* XB = (bf16*)(ws + WS_XB);
    bf16* BIG = (bf16*)(ws + WS_BIG);
    bf16* QKV = BIG; bf16* O0 = (bf16*)(ws + WS_BIG + 192 * MiB);
    bf16* PROJ = BIG; bf16* QC = (bf16*)(ws + WS_BIG + 144 * MiB); bf16* KVC = (bf16*)(ws + WS_BIG + 192 * MiB); bf16* O1 = (bf16*)(ws + WS_BIG + 256 * MiB);
    bf16* YB = BIG;
    float* stash_gf = (float*)(ws + WS_BIG + 192 * MiB); float* stash_uf = stash_gf + (size_t)(MTOK / 64) * 2 * FF; float* stash_gl = stash_uf + (size_t)(MTOK / 64) * 2 * FF;
    using pg8::Gemm; using pg8::StaticOrder;

    { volatile LAS unsigned* misc0 = (volatile LAS unsigned*)(lds + RING_BYTES + 320); if (threadIdx.x < 32) misc0[threadIdx.x] = 0u; }
    __syncthreads();
    { const int tid = fresh_tid(), lane = tid & 63, wave = __builtin_amdgcn_readfirstlane(tid >> 6); p0_prologue(a, lds, bx * NWAVES + wave, NGW, lane, wave); }
    grid.sync();
    (void)xcd_barrier_post((unsigned*)(ws + WS_BAR), (volatile LAS unsigned*)(lds + RING_BYTES + 320) + 8);
#define XBAR() do { XcdBarrier xb_; xb_.bar = (unsigned*)(a.ws + WS_BAR); xb_.x = xb_xcc_id(); xb_.st = (volatile LAS unsigned*)(lds + RING_BYTES + 320) + 8; xcd_barrier(xb_); } while (0)


#ifndef SKIP_P1
    { Gemm g{XB, (const bf16*)(ws + WS_W_AB), MTOK, AB_COLS, DM, DM}; StaticOrder S; S.init(MTOK, AB_COLS, G, bx);
      pg8::EpiScaleBf16 E{QKV, AB_COLS, ss0, 1.0f / DM};
      pg8::gemm_phase<pg8::EpiScaleBf16, StaticOrder, true, true>(lds, g, S, E); }
#endif
    XBAR();

#ifndef SKIP_ATT0
    { att::Ptrs PA{QKV, AB_COLS, 64, QKV + 512, AB_COLS, 64, nullptr, 0, QKV + 1024, AB_COLS, 64, O0, 0, a.ab_rel_bias, nullptr};
      att::Ptrs PB{QKV + 1536, AB_COLS, 64, QKV + 2048, AB_COLS, 64, nullptr, 0, QKV + 2560, AB_COLS, 64, O0, 512, nullptr, nullptr};
      attn_phase<0>(PA, PB, qctr, lds); }
#endif
    XBAR();

#ifndef SKIP_P3
    { Gemm g{O0, (const bf16*)(ws + WS_W_OAB), MTOK, DM, DM, DM}; StaticOrder S; S.init(MTOK, DM, G, bx);
      pg8::EpiResid E{a.x, nullptr, nullptr, XB, ss1};
      pg8::gemm_phase<pg8::EpiResid, StaticOrder, true, true>(lds, g, S, E); }
#endif
    XBAR();
#pragma unroll 1
    for (int layer = 0; layer < 2; ++layer) {

#ifndef SKIP_GU
        { Gemm g{XB, (const bf16*)(ws + (layer ? WS_W_GU1 : WS_W_GU0)), MTOK, FF2, DM, DM}; StaticOrder S; S.init(MTOK, FF2, G, bx);
          pg8::EpiGU E{YB, layer ? ss3 : ss1, a.ffn_conv_w + (size_t)layer * 3 * FF, a.ffn_conv_b + (size_t)layer * FF, stash_gf, stash_uf, stash_gl};
          pg8::gemm_phase<pg8::EpiGU, StaticOrder, true, true>(lds, g, S, E); }
#endif
        XBAR();

#ifndef SKIP_ACT
        ffn_fixup(stash_gf, stash_uf, stash_gl, a.ffn_conv_w + (size_t)layer * 3 * FF, a.ffn_conv_b + (size_t)layer * FF, YB, bx * NTHR + fresh_tid(), GT);
#endif
        XBAR();

#ifndef SKIP_DN
        { Gemm g{YB, (const bf16*)(ws + (layer ? WS_W_DN1 : WS_W_DN0)), MTOK, DM, FF, FF}; StaticOrder S; S.init(MTOK, DM, G, bx);
          pg8::EpiResid E{nullptr, XB, nullptr, XB, layer ? ss4 : ss2};
          pg8::gemm_phase<pg8::EpiResid, StaticOrder, true, true>(lds, g, S, E); }
#endif
        XBAR();
        if (layer == 0) {

#ifndef SKIP_CD
            { Gemm g{XB, (const bf16*)(ws + WS_W_CD), MTOK, CD_PAD, DM, DM}; StaticOrder S; S.init(MTOK, CD_PAD, G, bx);
              pg8::EpiCD E{PROJ, ss2, ssq, sskv, lf, a.cd_b_f, (const pg8::f32x2*)rope};
              pg8::gemm_phase<pg8::EpiCD, StaticOrder, true, true>(lds, g, S, E); }
#endif
            XBAR();

#ifndef SKIP_P8
#ifndef SKIP_CUMF
            kmax_block(PROJ + 1184, (unsigned*)(ws + WS_KMAX), bx, fresh_tid());
            if (bx < 32) cumf_block(lf, cumf, bx, (LAS float*)lds, fresh_tid());
#endif
#ifndef SKIP_QUP
            { Gemm g{PROJ, (const bf16*)(ws + WS_W_UQ), MTOK, QC_COLS, Q_RANK, CD_PAD}; StaticOrder S; S.init(MTOK, QC_COLS, G, bx);
              pg8::EpiQ E{QC, ssq, (const pg8::f32x2*)rope};
              pg8::gemm_phase<pg8::EpiQ, StaticOrder, true, true>(lds, g, S, E); }
#endif
#ifndef SKIP_KVUP
            { Gemm g{PROJ + Q_RANK, (const bf16*)(ws + WS_W_UKV), MTOK, KVC_COLS, KV_RANK, CD_PAD}; StaticOrder S; S.init(MTOK, KVC_COLS, G, bx);
              pg8::EpiScaleBf16 E{KVC, KVC_COLS, sskv, 1.0f / KV_RANK};
              pg8::gemm_phase<pg8::EpiScaleBf16, StaticOrder, true, true>(lds, g, S, E); }
#endif
#endif
            XBAR();

#ifndef SKIP_ATT1
            { att::Ptrs PC{QC, QC_COLS, 96, KVC, KVC_COLS, 128, PROJ + 640, CD_PAD, KVC + 64, KVC_COLS, 128, O1, 0, nullptr, nullptr};
              att::Ptrs PD{PROJ + 672, CD_PAD, 64, PROJ + 1184, CD_PAD, 64, nullptr, 0, PROJ + 1696, CD_PAD, 64, O1, 512, cumf, kmaxp};
              attn_phase<1>(PC, PD, qctr + 8 * 64, lds); }
#endif
            XBAR();

#ifndef SKIP_P10
            { Gemm g{O1, (const bf16*)(ws + WS_W_OCD), MTOK, DM, DM, DM}; StaticOrder S; S.init(MTOK, DM, G, bx);
              pg8::EpiResid E{nullptr, XB, nullptr, XB, ss3};
              pg8::gemm_phase<pg8::EpiResid, StaticOrder, true, true>(lds, g, S, E); }
#endif
            XBAR();
        }
    }
    const int tidf = fresh_tid(), lane = tidf & 63, gw = bx * NWAVES + __builtin_amdgcn_readfirstlane(tidf >> 6);
    { const f32x4* gr = (const f32x4*)a.final_norm + lane; f32x4 gg[4];
#pragma unroll
      for (int j = 0; j < 4; ++j) gg[j] = gr[64 * j];
      for (int m0 = gw * 4; m0 < MTOK; m0 += NGW * 4) { unsigned long long v[4][4]; float rs[4];
#pragma unroll
          for (int r = 0; r < 4; ++r) { const unsigned long long* xr = (const unsigned long long*)(XB + (size_t)(m0 + r) * DM) + lane; rs[r] = rsqrtf(ss4[m0 + r] * (1.0f / DM) + RMS_EPS);
#pragma unroll
              for (int j = 0; j < 4; ++j) v[r][j] = xr[64 * j]; }
#pragma unroll
          for (int r = 0; r < 4; ++r) { f32x4* xw = (f32x4*)(a.out + (size_t)(m0 + r) * DM) + lane;
#pragma unroll
              for (int j = 0; j < 4; ++j) { const unsigned lo = (unsigned)v[r][j], hi = (unsigned)(v[r][j] >> 32); const f32x4 x4 = {bf_lo(lo), bf_hi(lo), bf_lo(hi), bf_hi(hi)};
                  __builtin_nontemporal_store(x4 * rs[r] * gg[j], xw + 64 * j); } } } }
}

extern "C" void kernel_launch(void* const* d_in, const int* in_sizes, int n_in, void* d_out, int out_size, void* d_ws, size_t ws_size, hipStream_t stream) {
    static int grid = 0;
    if (grid == 0) {
        if (n_in != 20 || in_sizes[0] != MTOK * DM || out_size != MTOK * DM || ws_size < WS_END) { fprintf(stderr, "kernel_launch: unexpected shapes / workspace (n_in %d, in0 %d, out %d, ws %zu, need %zu)\n", n_in, n_in > 0 ? in_sizes[0] : -1, out_size, ws_size, (size_t)WS_END); grid = -1; return; }
        int dev = 0, cus = 0, per_cu = 0;
        if (hipGetDevice(&dev) != hipSuccess || hipDeviceGetAttribute(&cus, hipDeviceAttributeMultiprocessorCount, dev) != hipSuccess) { grid = -1; return; }
        if (hipFuncSetAttribute((const void*)mk_fwd, hipFuncAttributeMaxDynamicSharedMemorySize, LDS_BYTES) != hipSuccess) { fprintf(stderr, "kernel_launch: hipFuncSetAttribute failed\n"); grid = -1; return; }
        if (hipOccupancyMaxActiveBlocksPerMultiprocessor(&per_cu, (const void*)mk_fwd, NTHR, LDS_BYTES) != hipSuccess || per_cu < 1) { fprintf(stderr, "kernel_launch: occupancy query says %d blocks per CU\n", per_cu); }
        (void)hipGetLastError();
        grid = cus;
    }
    if (grid < 0) return;
    Args a{};
    const float** p = (const float**)&a;
    for (int i = 0; i < 20; ++i) p[i] = (const float*)d_in[i];
    a.out = (float*)d_out; a.ws = (unsigned char*)d_ws;
    void* args[] = {&a};
    hipError_t e = hipLaunchCooperativeKernel((const void*)mk_fwd, dim3(grid), dim3(NTHR), args, LDS_BYTES, stream);
    if (e != hipSuccess) fprintf(stderr, "cooperative launch failed: %s (grid %d)\n", hipGetErrorString(e), grid);
}
```
